# Optimizing an MI355X kernel written in HIP

```python
import math
import jax, jax.numpy as jnp
from jax import lax
import numpy as np

D_MODEL = 1024
BATCH = 16
SEQ = 2048
DEPTH = 2

GRID_W = 64
CTX_LEN = 256
CONV_DIM = 512
CONV_W = 3
SSM_DIM = 512
SSM_GROUP = 16
SSM_GROUPS = SSM_DIM // SSM_GROUP
SSM_STATE = 64
DT_MIN = 1e-3
DT_MAX = 1e-1
N_HEADS = 8
N_KV_HEADS = 2
HEAD_DIM = 128
GQA_GROUP = N_HEADS // N_KV_HEADS
ATTN_DIM = N_HEADS * HEAD_DIM
KV_DIM = N_KV_HEADS * HEAD_DIM
Q_BLOCK = 128
ROPE_THETA = 10000.0
ATTN_SCALE = HEAD_DIM ** -0.5
N_BRANCH = 3
D_FF = 2816
LN_EPS = 1e-6
RMS_EPS = 1e-6
DEEPNORM_ALPHA = (2 * DEPTH) ** 0.25
DEEPNORM_BETA = (8 * DEPTH) ** -0.25
COL_SIZES = (KV_DIM, KV_DIM, SSM_DIM, ATTN_DIM, CONV_DIM, CONV_DIM, CONV_DIM, N_BRANCH * D_MODEL)
N_CTX_KEEP = 3
IN_COLS = sum(COL_SIZES)

kernel_name = 'hybrid_conv_s5_gqa_dit_block'


def _layernorm(t):
    tf = t.astype(jnp.float32)
    mu = jnp.mean(tf, -1, keepdims=True)
    var = jnp.mean(jnp.square(tf - mu), -1, keepdims=True)
    return ((tf - mu) * lax.rsqrt(var + LN_EPS)).astype(t.dtype)


def _rmsnorm(t, g):
    tf = t.astype(jnp.float32)
    return (tf * lax.rsqrt(jnp.mean(tf * tf, -1, keepdims=True) + RMS_EPS)).astype(t.dtype) * g


def _modulate(t, shift, scale):
    return _layernorm(t) * (1.0 + scale) + shift


def _split_cols(z, n_groups):
    parts, off = [], 0
    for size in COL_SIZES[:n_groups]:
        parts.append(z[..., off:off + size])
        off += size
    return parts


def _dwconv(t, w):
    pad = CONV_W // 2
    n = t.shape[1]
    tp = jnp.pad(t, ((0, 0), (pad, pad), (0, 0)))
    out = tp[:, 0:n] * w[0]
    for k in range(1, CONV_W):
        out = out + tp[:, k:k + n] * w[k]
    return out


def _heads(t, n):
    return t.reshape(t.shape[:-1] + (n, HEAD_DIM))


def _axial_rope(rows):
    half = HEAD_DIM // 2
    inv_freq = 1.0 / (ROPE_THETA ** (jnp.arange(0, half, 2, dtype=jnp.float32) / half))
    row = jnp.repeat(jnp.arange(rows, dtype=jnp.float32), GRID_W)
    col = jnp.tile(jnp.arange(GRID_W, dtype=jnp.float32), rows)
    ang = jnp.concatenate([row[:, None] * inv_freq, col[:, None] * inv_freq], -1)
    return jnp.cos(ang), jnp.sin(ang)


def _apply_rope(t, cos, sin):
    tf = t.astype(jnp.float32).reshape(t.shape[:-1] + (HEAD_DIM // 2, 2))
    te, to = tf[..., 0], tf[..., 1]
    cs, sn = cos[:, None, :], sin[:, None, :]
    out = jnp.stack([te * cs - to * sn, te * sn + to * cs], -1)
    return out.reshape(t.shape).astype(t.dtype)


def _attend(q, k, v):
    b, tq = q.shape[:2]
    qg = q.reshape(b, tq, N_KV_HEADS, GQA_GROUP, HEAD_DIM)
    s = jnp.einsum('bqkgd,bskd->bkgqs', qg, k).astype(jnp.float32) * ATTN_SCALE
    p = jax.nn.softmax(s, axis=-1).astype(v.dtype)
    o = jnp.einsum('bkgqs,bskd->bqkgd', p, v)
    return o.reshape(b, tq, ATTN_DIM)


def _block_attention(q, k, v):
    b, n = q.shape[:2]
    qb = q.reshape(b, n // Q_BLOCK, Q_BLOCK, N_HEADS, HEAD_DIM).swapaxes(0, 1)
    o = lax.map(lambda blk: _attend(blk, k, v), qb)
    return o.swapaxes(0, 1).reshape(b, n, ATTN_DIM)


def _zoh(lam_re, lam_im, log_dt, b_re, b_im):
    lam = lax.complex(lam_re.astype(jnp.float32), lam_im.astype(jnp.float32))
    dt = jnp.exp(log_dt.astype(jnp.float32))[:, None]
    lam_bar = jnp.exp(lam * dt)
    bmat = lax.complex(b_re.astype(jnp.float32), b_im.astype(jnp.float32))
    b_bar = ((lam_bar - 1.0) / lam)[..., None] * bmat
    return lam_bar, b_bar


def _ssm_drive(u, b_bar):
    b, n = u.shape[:2]
    ug = u.astype(jnp.float32).reshape(b, n, SSM_GROUPS, SSM_GROUP).astype(jnp.complex64)
    return jnp.einsum('btgh,gph->tbgp', ug, b_bar)


def _diag_scan(lam_bar, bu, reverse):
    a = jnp.broadcast_to(lam_bar, (bu.shape[0], 1) + lam_bar.shape)

    def combine(left, right):
        a_l, b_l = left
        a_r, b_r = right
        return a_r * a_l, a_r * b_l + b_r

    _, s = lax.associative_scan(combine, (a, bu), reverse=reverse, axis=0)
    return s


def _ssm_readout(s, c_mat):
    n, b = s.shape[:2]
    return jnp.real(jnp.einsum('tbgp,ghp->btgh', s, c_mat)).reshape(b, n, SSM_DIM)


def _s5_mixer(u_lat, u_ctx, lam_re, lam_im, log_dt, b_re, b_im, c_re, c_im, ssm_d, need_ctx_out):
    y_lat = ssm_d * u_lat.astype(jnp.float32)
    y_ctx = ssm_d * u_ctx.astype(jnp.float32) if need_ctx_out else None
    for d, reverse in enumerate((False, True)):
        lam_bar, b_bar = _zoh(lam_re[d], lam_im[d], log_dt[d], b_re[d], b_im[d])
        c_mat = lax.complex(c_re[d].astype(jnp.float32), c_im[d].astype(jnp.float32))
        s_ctx = _diag_scan(lam_bar, _ssm_drive(u_ctx, b_bar), reverse)
        s_end = s_ctx[0] if reverse else s_ctx[-1]
        first = -1 if reverse else 0
        bu_lat = _ssm_drive(u_lat, b_bar).at[first].add(lam_bar * s_end)
        s_lat = _diag_scan(lam_bar, bu_lat, reverse)
        y_lat = y_lat + _ssm_readout(s_lat, c_mat)
        if need_ctx_out:
            y_ctx = y_ctx + _ssm_readout(s_ctx, c_mat)
    return y_lat.astype(u_lat.dtype), (y_ctx.astype(u_ctx.dtype) if need_ctx_out else None)


def _glu(y, w_glu):
    a, g = jnp.split(jax.nn.gelu(y) @ w_glu, 2, axis=-1)
    return a * jax.nn.sigmoid(g)


def _merge(gate_logits, y_conv, y_ssm, y_attn):
    g_conv, g_ssm, g_attn = jnp.split(jax.nn.sigmoid(gate_logits), N_BRANCH, axis=-1)
    return g_conv * y_conv + g_ssm * y_ssm + g_attn * y_attn


def _token_mixer(h_lat, h_ctx, cos, sin, w_in, conv_w, w_conv_out,
                 lam_re, lam_im, log_dt, b_re, b_im, c_re, c_im, ssm_d, w_glu,
                 q_norm_g, k_norm_g, w_attn_out, w_o, need_ctx_out):
    n_ctx_groups = len(COL_SIZES) if need_ctx_out else N_CTX_KEEP
    z_lat = h_lat @ w_in
    z_ctx = h_ctx @ w_in[:, :sum(COL_SIZES[:n_ctx_groups])]
    k_l, v_l, u_l, q_l, ax_l, bg_l, cg_l, gt_l = _split_cols(z_lat, len(COL_SIZES))
    ctx_parts = _split_cols(z_ctx, n_ctx_groups)
    k_c, v_c, u_c = ctx_parts[:N_CTX_KEEP]

    k_c = _rmsnorm(_heads(k_c, N_KV_HEADS), k_norm_g)
    v_c = _heads(v_c, N_KV_HEADS)
    k_l = _apply_rope(_rmsnorm(_heads(k_l, N_KV_HEADS), k_norm_g), cos, sin)
    q_l = _apply_rope(_rmsnorm(_heads(q_l, N_HEADS), q_norm_g), cos, sin)
    k_all = jnp.concatenate([k_c, k_l], axis=1)
    v_all = jnp.concatenate([v_c, _heads(v_l, N_KV_HEADS)], axis=1)
    attn_lat = _block_attention(q_l, k_all, v_all) @ w_attn_out

    s5_lat, s5_ctx = _s5_mixer(u_l, u_c, lam_re, lam_im, log_dt, b_re, b_im, c_re, c_im, ssm_d, need_ctx_out)
    ssm_lat = _glu(s5_lat, w_glu)

    conv_lat = (bg_l * _dwconv(cg_l * ax_l, conv_w)) @ w_conv_out

    out_lat = _merge(gt_l, conv_lat, ssm_lat, attn_lat) @ w_o
    if not need_ctx_out:
        return out_lat, None

    q_c, ax_c, bg_c, cg_c, gt_c = ctx_parts[N_CTX_KEEP:]
    q_c = _rmsnorm(_heads(q_c, N_HEADS), q_norm_g)
    attn_ctx = _attend(q_c, k_c, v_c) @ w_attn_out
    ssm_ctx = _glu(s5_ctx, w_glu)
    conv_ctx = (bg_c * _dwconv(cg_c * ax_c, conv_w)) @ w_conv_out
    out_ctx = _merge(gt_c, conv_ctx, ssm_ctx, attn_ctx) @ w_o
    return out_lat, out_ctx


def _conv_ffn(h, w_up, conv_w, conv_b, w_down):
    u, v = jnp.split(h @ w_up, 2, axis=-1)
    return (jax.nn.gelu(_dwconv(u, conv_w) + conv_b) * v) @ w_down


def _post_norm(res, update, g, b):
    return _layernorm(DEEPNORM_ALPHA * res + update) * g + b


def setup_inputs(seed: int = 0) -> dict:
    key = jax.random.key(seed)
    keys = iter(jax.random.split(key, 40))

    def nrm(shape, std):
        return std * jax.random.normal(next(keys), shape, dtype=jnp.float32)

    L, D = DEPTH, D_MODEL
    G, P, H = SSM_GROUPS, SSM_STATE, SSM_GROUP
    lam_re = -0.5 + nrm((L, 2, G, P), 0.01)
    lam_im = jnp.pi * jnp.arange(P, dtype=jnp.float32) + nrm((L, 2, G, P), 0.01)
    log_dt = jax.random.uniform(next(keys), (L, 2, G), jnp.float32, math.log(DT_MIN), math.log(DT_MAX))
    return {
        'x': nrm((BATCH, SEQ, D), 1.0),
        'c': nrm((BATCH, D), 1.0),
        'ctx': nrm((BATCH, CTX_LEN, D), 1.0),
        'c_ctx': nrm((D,), 1.0),
        'w_mod': nrm((L, D, 6 * D), 0.5 * D ** -0.5),
        'b_mod': nrm((L, 6 * D), 0.02),
        'w_in': nrm((L, D, IN_COLS), D ** -0.5),
        'conv_w': nrm((L, CONV_W, CONV_DIM), CONV_W ** -0.5),
        'w_conv_out': nrm((L, CONV_DIM, D), CONV_DIM ** -0.5),
        'ssm_lam_re': lam_re,
        'ssm_lam_im': lam_im,
        'ssm_log_dt': log_dt,
        'ssm_b_re': nrm((L, 2, G, P, H), (2 * H) ** -0.5),
        'ssm_b_im': nrm((L, 2, G, P, H), (2 * H) ** -0.5),
        'ssm_c_re': nrm((L, 2, G, H, P), 0.5),
        'ssm_c_im': nrm((L, 2, G, H, P), 0.5),
        'ssm_d': nrm((L, SSM_DIM), 1.0),
        'w_glu': nrm((L, SSM_DIM, 2 * D), SSM_DIM ** -0.5),
        'q_norm_g': 1.0 + nrm((L, HEAD_DIM), 0.02),
        'k_norm_g': 1.0 + nrm((L, HEAD_DIM), 0.02),
        'w_attn_out': nrm((L, ATTN_DIM, D), ATTN_DIM ** -0.5),
        'w_o': nrm((L, D, D), DEEPNORM_BETA * D ** -0.5),
        'ln1_g': 1.0 + nrm((L, D), 0.02),
        'ln1_b': nrm((L, D), 0.02),
        'ffn_w_up': nrm((L, D, 2 * D_FF), D ** -0.5),
        'ffn_conv_w': nrm((L, CONV_W, D_FF), CONV_W ** -0.5),
        'ffn_conv_b': nrm((L, D_FF), 0.02),
        'ffn_w_down': nrm((L, D_FF, D), DEEPNORM_BETA * D_FF ** -0.5),
        'ln2_g': 1.0 + nrm((L, D), 0.02),
        'ln2_b': nrm((L, D), 0.02),
    }


def reference(x, c, ctx, c_ctx, w_mod, b_mod, w_in, conv_w, w_conv_out,
              ssm_lam_re, ssm_lam_im, ssm_log_dt, ssm_b_re, ssm_b_im, ssm_c_re, ssm_c_im, ssm_d, w_glu,
              q_norm_g, k_norm_g, w_attn_out, w_o, ln1_g, ln1_b,
              ffn_w_up, ffn_conv_w, ffn_conv_b, ffn_w_down, ln2_g, ln2_b):
    rows = x.shape[1] // GRID_W
    cos, sin = _axial_rope(rows)
    sc = jax.nn.silu(c)
    sc_ctx = jax.nn.silu(c_ctx)
    for i in range(DEPTH):
        last = i == DEPTH - 1
        mod_lat = (sc @ w_mod[i] + b_mod[i])[:, None, :]
        mod_ctx = sc_ctx @ w_mod[i] + b_mod[i]
        sh1, sc1, g1, sh2, sc2, g2 = jnp.split(mod_lat, 6, axis=-1)
        csh1, csc1, cg1, csh2, csc2, cg2 = jnp.split(mod_ctx, 6, axis=-1)

        m_lat, m_ctx = _token_mixer(
            _modulate(x, sh1, sc1), _modulate(ctx, csh1, csc1), cos, sin,
            w_in[i], conv_w[i], w_conv_out[i],
            ssm_lam_re[i], ssm_lam_im[i], ssm_log_dt[i], ssm_b_re[i], ssm_b_im[i],
            ssm_c_re[i], ssm_c_im[i], ssm_d[i], w_glu[i],
            q_norm_g[i], k_norm_g[i], w_attn_out[i], w_o[i], not last)
        x = _post_norm(x, g1 * m_lat, ln1_g[i], ln1_b[i])
        f_lat = _conv_ffn(_modulate(x, sh2, sc2), ffn_w_up[i], ffn_conv_w[i], ffn_conv_b[i], ffn_w_down[i])
        x = _post_norm(x, g2 * f_lat, ln2_g[i], ln2_b[i])

        if not last:
            ctx = _post_norm(ctx, cg1 * m_ctx, ln1_g[i], ln1_b[i])
            f_ctx = _conv_ffn(_modulate(ctx, csh2, csc2), ffn_w_up[i], ffn_conv_w[i], ffn_conv_b[i], ffn_w_down[i])
            ctx = _post_norm(ctx, cg2 * f_ctx, ln2_g[i], ln2_b[i])
    return x
```

```cpp
#include <hip/hip_runtime.h>
#include <hip/hip_cooperative_groups.h>
#include <cstdio>
#include <cstdint>
namespace cg = cooperative_groups;

#ifndef PROBE_MASK
#define PROBE_MASK 0
#endif
#ifndef MK_MULTI
#define MK_MULTI 0
#endif

#define LAS __attribute__((address_space(3)))
typedef unsigned short bf16_t;
typedef short bf16x8 __attribute__((ext_vector_type(8)));
typedef short s16x4 __attribute__((ext_vector_type(4)));
typedef float f32x4 __attribute__((ext_vector_type(4)));
typedef float f32x2 __attribute__((ext_vector_type(2)));
typedef float f32x16 __attribute__((ext_vector_type(16)));
typedef unsigned u32x4 __attribute__((ext_vector_type(4)));
typedef unsigned u32x2 __attribute__((ext_vector_type(2)));

constexpr int D = 1024, NBATCH = 16, SEQ = 2048, CTX = 256, DEPTH = 2;
constexpr int HBT = 8;
constexpr int ML = HBT * SEQ, MC = HBT * CTX, MH = ML + MC;
constexpr int INC = 6656, DFF = 2816, SEQA = SEQ + CTX;
constexpr int NCH = SEQA / 16, A2R = 2048;
constexpr float LN_EPS = 1e-6f, RMS_EPS = 1e-6f;
constexpr float DN_ALPHA = 1.4142135623730951f;

constexpr size_t MiB = 1u << 20;
constexpr size_t WS_MODV = 1 * MiB;
constexpr size_t WS_ROPE = 2 * MiB;
constexpr size_t WS_LP = 3 * MiB;
constexpr size_t WS_KT = 5 * MiB;
constexpr size_t WS_EB = 8 * MiB;
constexpr size_t WS_TR = 16 * MiB;
constexpr size_t WS_CTXRES = 32 * MiB;
constexpr size_t WS_WB = 48 * MiB;
constexpr size_t WS_H = 86 * MiB;
constexpr size_t WS_BIG = 158 * MiB;
constexpr size_t WS_KB = WS_BIG, WS_VB = WS_KB + 9 * MiB, WS_QO = WS_VB + 9 * MiB, WS_AX = WS_QO + 36 * MiB, WS_BG = WS_AX + 18 * MiB,
                 WS_CG = WS_BG + 18 * MiB, WS_GT = WS_CG + 18 * MiB, WS_A2 = WS_GT + 108 * MiB, WS_MIX_END = WS_A2 + 64 * MiB;
constexpr size_t WS_E2 = WS_MIX_END;
constexpr size_t WS_O2 = WS_E2 + 36 * MiB;
constexpr size_t WS_MG = WS_E2;

constexpr size_t WS_FACT = WS_H + 72 * MiB  , WS_FSB = WS_FACT + 198 * MiB, WS_FEND = WS_FSB + 10 * MiB;
static_assert(WS_FEND <= 512 * MiB, "ws map");
constexpr size_t WS_UV = WS_BIG, WS_ACT = WS_UV + 198 * MiB, WS_SB = WS_ACT + 99 * MiB, WS_END = WS_SB + 5 * MiB;
static_assert(WS_O2 + 36 * MiB <= 512 * MiB && WS_END <= 512 * MiB, "ws map");
constexpr size_t WO_IN = 0, WO_CO = WO_IN + (size_t)INC * D, WO_GLU = WO_CO + (size_t)D * 512, WO_AO = WO_GLU + (size_t)2048 * 512,
                 WO_O = WO_AO + (size_t)D * D, WO_UP = WO_O + (size_t)D * D, WO_DN = WO_UP + (size_t)2 * DFF * D, WO_END = WO_DN + (size_t)D * DFF;
static_assert(WO_END * 2 <= 38 * MiB, "weights");

constexpr int LDS_BYTES = 131072 + 1024 + 8192;

__device__ __forceinline__ unsigned opq(unsigned v) { asm volatile("" : "+s"(v)); return v; }
#define WSP(off) (ws + ((size_t)opq((unsigned)((off) >> 20)) << 20))
__device__ __forceinline__ unsigned cvt_pk_bf16(float lo, float hi) { unsigned r; asm volatile("v_cvt_pk_bf16_f32 %0, %1, %2" : "=v"(r) : "v"(lo), "v"(hi)); return r; }
__device__ __forceinline__ float bflo(unsigned w) { return __uint_as_float(w << 16); }
__device__ __forceinline__ float bfhi(unsigned w) { return __uint_as_float(w & 0xffff0000u); }
__device__ __forceinline__ float sigm(float x) { return __builtin_amdgcn_rcpf(1.0f + __builtin_amdgcn_exp2f(-1.4426950408889634f * x)); }
__device__ __forceinline__ float gelu_t(float x) { const float e = __builtin_amdgcn_exp2f(x * fmaf(x * x, -0.10294324f, -2.3022082f)); return x * __builtin_amdgcn_rcpf(1.0f + e); }
__device__ __forceinline__ float wave_sum(float v) {
#pragma unroll
    for (int o = 1; o < 64; o <<= 1) v += __shfl_xor(v, o);
    return v;
}
__device__ __forceinline__ void unpack8(u32x4 w, float* f) { f[0] = bflo(w.x); f[1] = bfhi(w.x); f[2] = bflo(w.y); f[3] = bfhi(w.y); f[4] = bflo(w.z); f[5] = bfhi(w.z); f[6] = bflo(w.w); f[7] = bfhi(w.w); }
__device__ __forceinline__ u32x4 pack8(const float* f) { u32x4 w; w.x = cvt_pk_bf16(f[0], f[1]); w.y = cvt_pk_bf16(f[2], f[3]); w.z = cvt_pk_bf16(f[4], f[5]); w.w = cvt_pk_bf16(f[6], f[7]); return w; }

namespace pg8 {
constexpr int BM = 256, BK = 64, HALF = 128, HTB = HALF * BK * 2, STAGE_BYTES = 8 * HTB, NXCD = 8, WGM = 8;
__host__ __device__ __forceinline__ int lds_byte(int r, int c) { const int st = (r >> 4) * 2 + (c >> 5), rr = r & 15, cc = c & 31, ob = rr * 64 + cc * 2; return st * 1024 + (ob ^ (((ob >> 9) & 1) << 5)); }
__host__ __device__ __forceinline__ void stage_rc(int b, int& R, int& C) { const int st = b / 1024, sb = b % 1024, swz = sb ^ (((sb >> 9) & 1) << 5); R = (st >> 1) * 16 + swz / 64; C = (st & 1) * 32 + (swz % 64) / 2; }
__host__ __device__ __forceinline__ int perm32(int rho) { const int n = rho >> 4, i = rho & 15; return 8 * (i >> 2) + 4 * n + (i & 3); }

struct Unit { int pm, pn; };
struct Gemm { const bf16_t* A; const bf16_t* Bt; };

struct Order {
    int nM, nN, nwg, G, c, xM0, xNN, xcnt, sub;
    __device__ __forceinline__ void init(int nM_, int nN_, int G_, int c_) { nM = nM_; nN = nN_; nwg = nM * nN; G = G_; c = c_; xM0 = 0; xNN = 1; xcnt = 0; sub = 1; }
    __device__ __forceinline__ bool next(int i, Unit& u) const {
        const int ib = i / sub, is = i - ib * sub;
        long L = (long)ib * G + c;
        if (L < nwg) {
            int wgid = (int)L; { const int q = nwg / NXCD, r = nwg % NXCD, xcd = wgid % NXCD, off = wgid / NXCD; wgid = (xcd < r ? xcd * (q + 1) : r * (q + 1) + (xcd - r) * q) + off; }
            const int nig = WGM * nN, gid = wgid / nig, fm = gid * WGM, gsz = (nM - fm) < WGM ? (nM - fm) : WGM;
            u.pm = fm + ((wgid % nig) % gsz); u.pn = ((wgid % nig) / gsz) * sub + is; return true;
        }
        L -= nwg; if (L >= xcnt) return false;
        u.pm = xM0 + (int)L / xNN; u.pn = ((int)L % xNN) * sub + is; return true;
    }
};
struct OneUnit {
    int pm, pn;
    __device__ __forceinline__ bool next(int i, Unit& u) const { if (i != 0) return false; u.pm = pm; u.pn = pn; return true; }
};

template <int LDA, int LDB, int KK, class Epi, class Sched>
__device__ __forceinline__ void gemm_phase(LAS unsigned char* lds, const Gemm g, const Sched& S, const Epi& E, const int tid) {
    const int wid = __builtin_amdgcn_readfirstlane(tid >> 6), lane = tid & 63, wr = wid >> 2, wc = wid & 3, fr = lane & 15, fq = lane >> 4;
    constexpr int nt = KK / BK;
    unsigned voffA[2], voffB[2];
#pragma unroll
    for (int i = 0; i < 2; ++i) { int R, C; stage_rc(tid * 16 + i * 8192, R, C); const int Rb = Epi::PERM ? ((R & ~31) + perm32(R & 31)) : R;
        voffA[i] = (unsigned)(R * LDA + C) * 2u; voffB[i] = (unsigned)(Rb * LDB + C) * 2u; }
    constexpr size_t kstep = (size_t)(BK * 2);
    constexpr size_t hstepA = (size_t)HALF * LDA * 2, hstepB = (size_t)HALF * LDB * 2;
    constexpr size_t tstepA = 2 * hstepA, tstepB = 2 * hstepB;
    const unsigned ldsw = (unsigned)wid * 1024u;
    const int aoff = lds_byte(wr * 64 + fr, fq * 8), boff = lds_byte(wc * 32 + fr, fq * 8);
#define PG8_SA(b, h) (((b) * 2 + (h)) * HTB)
#define PG8_SB(b, h) ((4 + (b) * 2 + (h)) * HTB)
#define PG8_STAGE(bufoff, gbase, voff) do { _Pragma("unroll") for (int _i = 0; _i < 2; ++_i) \
        __builtin_amdgcn_global_load_lds((const unsigned*)((const char*)(gbase) + (voff)[_i]), (LAS unsigned*)(lds + (bufoff) + ldsw + _i * 8192), 16, 0, 0); } while (0)
#define PG8_LDA(dst, b, h) do { _Pragma("unroll") for (int m = 0; m < 4; ++m) _Pragma("unroll") for (int k = 0; k < 2; ++k) dst[m][k] = *(const LAS bf16x8*)(lds + PG8_SA(b, h) + aoff + m * 2048 + k * 1024); } while (0)
#define PG8_LDB(dst, b, h) do { _Pragma("unroll") for (int n = 0; n < 2; ++n) _Pragma("unroll") for (int k = 0; k < 2; ++k) dst[n][k] = *(const LAS bf16x8*)(lds + PG8_SB(b, h) + boff + n * 2048 + k * 1024); } while (0)
#define PG8_MMA(ai, bj, At, Bt) do { __builtin_amdgcn_s_setprio(1); _Pragma("unroll") for (int m = 0; m < 4; ++m) _Pragma("unroll") for (int n = 0; n < 2; ++n) _Pragma("unroll") for (int k = 0; k < 2; ++k) \
        acc[ai][bj][m][n] = __builtin_amdgcn_mfma_f32_16x16x32_bf16(Bt[n][k], At[m][k], acc[ai][bj][m][n], 0, 0, 0); __builtin_amdgcn_s_setprio(0); } while (0)
#define PG8_WAIT_V(n) asm volatile("s_waitcnt vmcnt(" #n ")" ::: "memory")
#define PG8_WAIT_L(n) asm volatile("s_waitcnt lgkmcnt(" #n ")" ::: "memory")
#define PG8_BAR __builtin_amdgcn_s_barrier()
#define PG8_SCHED __builtin_amdgcn_sched_barrier(0)
    Unit cur, nxt; int ui = 0;
    if (!S.next(0, cur)) return;
    f32x4 acc[2][2][4][2];
#pragma unroll
    for (int a = 0; a < 2; ++a)
#pragma unroll
        for (int b = 0; b < 2; ++b)
#pragma unroll
            for (int m = 0; m < 4; ++m)
#pragma unroll
                for (int n = 0; n < 2; ++n) acc[a][b][m][n] = (f32x4){0.f, 0.f, 0.f, 0.f};
    bf16x8 At[4][2], B0[2][2], B1[2][2];
    const char* cA = (const char*)g.A + (size_t)cur.pm * tstepA; const char* cB = (const char*)g.Bt + (size_t)cur.pn * tstepB;
    PG8_STAGE(PG8_SB(0, 0), cB, voffB); PG8_STAGE(PG8_SB(0, 1), cB + hstepB, voffB); PG8_STAGE(PG8_SA(0, 0), cA, voffA); PG8_STAGE(PG8_SA(0, 1), cA + hstepA, voffA);
    if (wr == 1) PG8_BAR;
    PG8_WAIT_V(2); PG8_BAR;
    PG8_STAGE(PG8_SB(1, 0), cB + kstep, voffB); PG8_STAGE(PG8_SA(1, 0), cA + kstep, voffA); PG8_STAGE(PG8_SB(1, 1), cB + hstepB + kstep, voffB);
    PG8_WAIT_V(6); PG8_BAR;
    for (;;) {
        const bool has_next = S.next(ui + 1, nxt);
        const char* nA = has_next ? (const char*)g.A + (size_t)nxt.pm * tstepA : cA; const char* nB = has_next ? (const char*)g.Bt + (size_t)nxt.pn * tstepB : cB;
#pragma unroll 1
        for (int t = 0; t < nt; t += 2) {
            const bool last = (t == nt - 2);
            const char* a1 = cA + (size_t)(t + 1) * kstep;
            const char* a2 = last ? nA : cA + (size_t)(t + 2) * kstep; const char* b2 = last ? nB : cB + (size_t)(t + 2) * kstep;
            const char* a3 = a2 + kstep; const char* b3 = b2 + kstep;
            PG8_LDB(B0, 0, 0); PG8_LDB(B1, 0, 1); PG8_SCHED; PG8_LDA(At, 0, 0); PG8_STAGE(PG8_SA(1, 1), a1 + hstepA, voffA);
            PG8_WAIT_V(8); PG8_WAIT_L(0); PG8_BAR; PG8_MMA(0, 0, At, B0); PG8_MMA(0, 1, At, B1); PG8_BAR; PG8_SCHED;
            PG8_LDA(At, 0, 1); PG8_STAGE(PG8_SB(0, 0), b2, voffB); PG8_STAGE(PG8_SB(0, 1), b2 + hstepB, voffB); PG8_STAGE(PG8_SA(0, 0), a2, voffA);
            PG8_WAIT_V(8); PG8_WAIT_L(0); PG8_BAR; PG8_MMA(1, 0, At, B0); PG8_MMA(1, 1, At, B1); PG8_BAR; PG8_SCHED;
            PG8_LDB(B0, 1, 0); PG8_LDB(B1, 1, 1); PG8_SCHED; PG8_LDA(At, 1, 0); PG8_STAGE(PG8_SA(0, 1), a2 + hstepA, voffA);
            PG8_WAIT_V(8); PG8_WAIT_L(0); PG8_BAR; PG8_MMA(0, 0, At, B0); PG8_MMA(0, 1, At, B1); PG8_BAR; PG8_SCHED;
            PG8_LDA(At, 1, 1); PG8_STAGE(PG8_SB(1, 0), b3, voffB); PG8_STAGE(PG8_SB(1, 1), b3 + hstepB, voffB); PG8_STAGE(PG8_SA(1, 0), a3, voffA);
            PG8_WAIT_V(8); PG8_WAIT_L(0); PG8_BAR; PG8_MMA(1, 0, At, B0); PG8_MMA(1, 1, At, B1); PG8_BAR; PG8_SCHED;
        }
        if (wr == 0) PG8_BAR;
        E(acc, cur, wr, wc, fr, fq);
        if (!has_next) break;
#pragma unroll
        for (int a = 0; a < 2; ++a)
#pragma unroll
            for (int b = 0; b < 2; ++b)
#pragma unroll
                for (int m = 0; m < 4; ++m)
#pragma unroll
                    for (int n = 0; n < 2; ++n) acc[a][b][m][n] = (f32x4){0.f, 0.f, 0.f, 0.f};
        cur = nxt; cA = nA; cB = nB; ++ui;
        if (wr == 1) PG8_BAR;
    }
    PG8_WAIT_V(0);
    PG8_BAR;
#undef PG8_SA
#undef PG8_SB
#undef PG8_STAGE
#undef PG8_LDA
#undef PG8_LDB
#undef PG8_MMA
#undef PG8_WAIT_V
#undef PG8_WAIT_L
#undef PG8_BAR
#undef PG8_SCHED
}

typedef const f32x4 (&AccRef)[2][2][4][2];
__device__ __forceinline__ u32x4 pack_acc(f32x4 v0, f32x4 v1) { u32x4 w; w.x = cvt_pk_bf16(v0[0], v0[1]); w.y = cvt_pk_bf16(v0[2], v0[3]); w.z = cvt_pk_bf16(v1[0], v1[1]); w.w = cvt_pk_bf16(v1[2], v1[3]); return w; }

struct EpiIn {
    static constexpr bool PERM = true;
    unsigned char* ws; const float* qg; const float* kg; LAS float* xs;
    __device__ __forceinline__ void operator()(AccRef acc, const Unit& u, int wr, int wc, int fr, int fq) const {
        bf16_t* const KB = (bf16_t*)WSP(WS_KB); bf16_t* const VB = (bf16_t*)WSP(WS_VB); bf16_t* const QO = (bf16_t*)WSP(WS_QO); bf16_t* const AX = (bf16_t*)WSP(WS_AX);
        bf16_t* const BG = (bf16_t*)WSP(WS_BG); bf16_t* const CG = (bf16_t*)WSP(WS_CG); bf16_t* const GT = (bf16_t*)WSP(WS_GT); bf16_t* const A2 = (bf16_t*)WSP(WS_A2);
        const int pn = u.pn, colw = wc * 32 + 8 * fq;
        if (pn == 0 || (pn >= 4 && pn < 8)) {
            const float* gv = (pn == 0 ? kg : qg) + colw; const f32x4 g0 = *(const f32x4*)gv, g1 = *(const f32x4*)(gv + 4);
            const float* ropec = (const float*)(ws + WS_ROPE); const float* ropes = ropec + 2048 * 64;
#pragma unroll
            for (int ai = 0; ai < 2; ++ai)
#pragma unroll
                for (int m = 0; m < 4; ++m)
#pragma unroll
                    for (int bj = 0; bj < 2; ++bj) { const f32x4 a0 = acc[ai][bj][m][0], a1 = acc[ai][bj][m][1];
                        float s2 = (a0[0] * a0[0] + a0[1] * a0[1]) + (a0[2] * a0[2] + a0[3] * a0[3]) + (a1[0] * a1[0] + a1[1] * a1[1]) + (a1[2] * a1[2] + a1[3] * a1[3]);
                        s2 += __shfl_xor(s2, 16); s2 += __shfl_xor(s2, 32);
                        if (fq == 0) xs[((ai * HALF + wr * 64 + m * 16 + fr) * 2 + bj) * 4 + wc] = s2; }
            asm volatile("s_waitcnt lgkmcnt(0)" ::: "memory"); __builtin_amdgcn_s_barrier(); asm volatile("" ::: "memory");
#pragma unroll
            for (int ai = 0; ai < 2; ++ai)
#pragma unroll
                for (int m = 0; m < 4; ++m) {
                    const int rt = ai * HALF + wr * 64 + m * 16 + fr, r = u.pm * BM + rt;
                    int bl, sp; if (r < ML) { bl = r >> 11; sp = 256 + (r & 2047); } else { const int rc = r - ML; bl = rc >> 8; sp = rc & 255; }
                    const bool rope = r < ML; f32x4 cs = {1.f, 1.f, 1.f, 1.f}, sn = {0.f, 0.f, 0.f, 0.f};
                    if (rope) { const int pi = (r & 2047) * 64 + 16 * wc + 4 * fq; cs = *(const f32x4*)(ropec + pi); sn = *(const f32x4*)(ropes + pi); }
#pragma unroll
                    for (int bj = 0; bj < 2; ++bj) {
                        const f32x4 ps = *(const LAS f32x4*)(xs + (rt * 2 + bj) * 4); const float rn = rsqrtf(((ps[0] + ps[1]) + (ps[2] + ps[3])) * (1.f / 128.f) + RMS_EPS);
                        f32x4 v0 = acc[ai][bj][m][0] * rn * g0, v1 = acc[ai][bj][m][1] * rn * g1;
                        const f32x4 w0 = {v0[0] * cs[0] - v0[1] * sn[0], v0[0] * sn[0] + v0[1] * cs[0], v0[2] * cs[1] - v0[3] * sn[1], v0[2] * sn[1] + v0[3] * cs[1]};
                        const f32x4 w1 = {v1[0] * cs[2] - v1[1] * sn[2], v1[0] * sn[2] + v1[1] * cs[2], v1[2] * cs[3] - v1[3] * sn[3], v1[2] * sn[3] + v1[3] * cs[3]};
                        const int c = bj * HALF + colw;
                        bf16_t* dst = pn == 0 ? (bf16_t*)(ws + WS_KB) + (size_t)(bl * SEQA + sp) * 256 + c : (bf16_t*)(ws + WS_QO) + (size_t)r * 1024 + (pn - 4) * 256 + c;
                        *(u32x4*)dst = pack_acc(w0, w1); }
                }
            return;
        }
#pragma unroll
        for (int ai = 0; ai < 2; ++ai)
#pragma unroll
            for (int m = 0; m < 4; ++m) {
                const int r = u.pm * BM + ai * HALF + wr * 64 + m * 16 + fr;
                int bl, sp; if (r < ML) { bl = r >> 11; sp = 256 + (r & 2047); } else { const int rc = r - ML; bl = rc >> 8; sp = rc & 255; }
#pragma unroll
                for (int bj = 0; bj < 2; ++bj) {
                    const int c = bj * HALF + colw; f32x4 v0 = acc[ai][bj][m][0], v1 = acc[ai][bj][m][1]; bf16_t* dst;
                    if (pn == 0) dst = KB + (size_t)(bl * SEQA + sp) * 256 + c;
                    else if (pn == 1) dst = VB + (size_t)(bl * SEQA + sp) * 256 + c;
                    else if (pn < 4) { const int cu = (pn - 2) * 256 + c, gg = cu >> 4, h0 = cu & 15; dst = A2 + ((size_t)(gg * A2R + bl * 256 + (sp >> 4)) * 512 + (sp & 15) * 16 + h0); }
                    else if (pn < 8) dst = QO + (size_t)r * 1024 + (pn - 4) * 256 + c;
                    else if (pn < 10) dst = AX + (size_t)r * 512 + (pn - 8) * 256 + c;
                    else if (pn < 12) dst = BG + (size_t)r * 512 + (pn - 10) * 256 + c;
                    else if (pn < 14) dst = CG + (size_t)r * 512 + (pn - 12) * 256 + c;
                    else { dst = GT + (size_t)r * 3072 + (pn - 14) * 256 + c;
#pragma unroll
                        for (int j = 0; j < 4; ++j) { v0[j] = sigm(v0[j]); v1[j] = sigm(v1[j]); } }
                    *(u32x4*)dst = pack_acc(v0, v1);
                }
            }
    }
};
struct EpiSsm1 {
    static constexpr bool PERM = true;
    bf16_t* A2;
    __device__ __forceinline__ void operator()(AccRef acc, const Unit& u, int wr, int wc, int fr, int fq) const {
        const int colw = wc * 32 + 8 * fq;
#pragma unroll
        for (int ai = 0; ai < 2; ++ai)
#pragma unroll
            for (int m = 0; m < 4; ++m) { const int r = u.pm * BM + ai * HALF + wr * 64 + m * 16 + fr;
#pragma unroll
                for (int bj = 0; bj < 2; ++bj) *(u32x4*)(A2 + (size_t)r * 256 + bj * HALF + colw) = pack_acc(acc[ai][bj][m][0], acc[ai][bj][m][1]); }
    }
};
struct EpiSsm2 {
    static constexpr bool PERM = true;
    bf16_t* Y;
    __device__ __forceinline__ void operator()(AccRef acc, const Unit& u, int wr, int wc, int fr, int fq) const {
        const int colw = wc * 32 + 8 * fq, gg = u.pn, bl = u.pm & 7;
#pragma unroll
        for (int ai = 0; ai < 2; ++ai)
#pragma unroll
            for (int m = 0; m < 4; ++m) { const int rl = ai * HALF + wr * 64 + m * 16 + fr;
                if (rl < NCH) { const int ch = rl;
#pragma unroll
                    for (int bj = 0; bj < 2; ++bj) { const int c = bj * HALF + colw, tau = c >> 4, h0 = c & 15, sp = ch * 16 + tau;
                        const int mrow = sp < 256 ? ML + bl * 256 + sp : bl * 2048 + sp - 256;
                        f32x4 v0 = acc[ai][bj][m][0], v1 = acc[ai][bj][m][1];
#pragma unroll
                        for (int j = 0; j < 4; ++j) { v0[j] = gelu_t(v0[j]); v1[j] = gelu_t(v1[j]); }
                        *(u32x4*)(Y + (size_t)mrow * 512 + gg * 16 + h0) = pack_acc(v0, v1); } } }
    }
};
template <int MODE  > struct EpiMerge {
    static constexpr bool PERM = true;
    unsigned char* ws;
    __device__ __forceinline__ void operator()(AccRef acc, const Unit& u, int wr, int wc, int fr, int fq) const {
        bf16_t* const MG = (bf16_t*)WSP(WS_MG); const bf16_t* const GT = (const bf16_t*)WSP(WS_GT);
        const int colw = wc * 32 + 8 * fq;
#pragma unroll
        for (int ai = 0; ai < 2; ++ai) {
            const int r0 = u.pm * BM + ai * HALF + wr * 64 + fr;
            if (MODE == 1) {
                const int c = u.pn * 128 + colw; u32x4 gtv[4], mgv[4];
#pragma unroll
                for (int m = 0; m < 4; ++m) { const int r = r0 + m * 16; gtv[m] = *(const u32x4*)(GT + (size_t)r * 3072 + 1024 + c); mgv[m] = *(const u32x4*)(MG + (size_t)r * 1024 + c); }
                asm volatile("s_waitcnt vmcnt(0)" ::: "memory");
#pragma unroll
                for (int m = 0; m < 4; ++m) { const int r = r0 + m * 16; float gt[8], mg[8], o[8]; unpack8(gtv[m], gt); unpack8(mgv[m], mg);
                    const f32x4 a0 = acc[ai][0][m][0], a1 = acc[ai][0][m][1], g0 = acc[ai][1][m][0], g1 = acc[ai][1][m][1];
#pragma unroll
                    for (int j = 0; j < 4; ++j) { o[j] = mg[j] + gt[j] * a0[j] * sigm(g0[j]); o[4 + j] = mg[4 + j] + gt[4 + j] * a1[j] * sigm(g1[j]); }
                    *(u32x4*)(MG + (size_t)r * 1024 + c) = pack8(o); }
            } else {
                u32x4 gtv[4][2], mgv[4][2];
#pragma unroll
                for (int m = 0; m < 4; ++m)
#pragma unroll
                    for (int bj = 0; bj < 2; ++bj) { const int r = r0 + m * 16, c = u.pn * 256 + bj * HALF + colw;
                        gtv[m][bj] = *(const u32x4*)(GT + (size_t)r * 3072 + (MODE == 0 ? 0 : 2048) + c);
                        if (MODE == 2) mgv[m][bj] = *(const u32x4*)(MG + (size_t)r * 1024 + c); }
                asm volatile("s_waitcnt vmcnt(0)" ::: "memory");
#pragma unroll
                for (int m = 0; m < 4; ++m)
#pragma unroll
                    for (int bj = 0; bj < 2; ++bj) { const int r = r0 + m * 16, c = u.pn * 256 + bj * HALF + colw; float gt[8], mg[8], o[8];
                        unpack8(gtv[m][bj], gt); if (MODE == 2) unpack8(mgv[m][bj], mg);
                        const f32x4 a0 = acc[ai][bj][m][0], a1 = acc[ai][bj][m][1];
#pragma unroll
                        for (int j = 0; j < 4; ++j) { o[j] = (MODE == 2 ? mg[j] : 0.f) + gt[j] * a0[j]; o[4 + j] = (MODE == 2 ? mg[4 + j] : 0.f) + gt[4 + j] * a1[j]; }
                        *(u32x4*)(MG + (size_t)r * 1024 + c) = pack8(o); }
            }
        }
    }
};
struct EpiRes {
    static constexpr bool PERM = false;
    const float *resL, *resC; float *outL, *outC; const float* gate;
    int hb, mlr;
    __device__ __forceinline__ void operator()(AccRef acc, const Unit& u, int wr, int wc, int fr, int fq) const {
        const bool lat = u.pm < mlr / BM;
        const float* res = lat ? resL : resC; float* out = lat ? outL : outC;
        const int col0 = u.pn * BM + wc * 32 + 4 * fq;
        const int bidx = lat ? hb + ((u.pm * BM) >> 11) : 16;
        const float* gp = gate + (size_t)bidx * 6144 + col0; f32x4 gv[2][2];
#pragma unroll
        for (int bj = 0; bj < 2; ++bj)
#pragma unroll
            for (int n = 0; n < 2; ++n) gv[bj][n] = *(const f32x4*)(gp + bj * HALF + n * 16);
#pragma unroll
        for (int ai = 0; ai < 2; ++ai) {
            const int r0 = u.pm * BM + ai * HALF + wr * 64 + fr; f32x4 rv[4][2][2];
#pragma unroll
            for (int m = 0; m < 4; ++m) { const int r = r0 + m * 16; const size_t off = (size_t)(lat ? r : r - mlr) * 1024 + col0;
#pragma unroll
                for (int bj = 0; bj < 2; ++bj)
#pragma unroll
                    for (int n = 0; n < 2; ++n) rv[m][bj][n] = *(const f32x4*)(res + off + bj * HALF + n * 16); }
            asm volatile("s_waitcnt vmcnt(0)" ::: "memory");
#pragma unroll
            for (int m = 0; m < 4; ++m) { const int r = r0 + m * 16; const size_t off = (size_t)(lat ? r : r - mlr) * 1024 + col0;
#pragma unroll
                for (int bj = 0; bj < 2; ++bj)
#pragma unroll
                    for (int n = 0; n < 2; ++n) *(f32x4*)(out + off + bj * HALF + n * 16) = rv[m][bj][n] * DN_ALPHA + gv[bj][n] * acc[ai][bj][m][n]; }
        }
    }
};
__device__ __forceinline__ float dpp_ror1(float x) { return __int_as_float(__builtin_amdgcn_mov_dpp(__float_as_int(x), 0x121, 0xf, 0xf, false)); }
__device__ __forceinline__ float dpp_rol1(float x) { return __int_as_float(__builtin_amdgcn_mov_dpp(__float_as_int(x), 0x12F, 0xf, 0xf, false)); }
struct EpiUp {
    static constexpr bool PERM = true;
    bf16_t* ACTp; float* SB; const float* fw; const float* fb; LAS float* xl;
    __device__ __forceinline__ void operator()(AccRef acc, const Unit& u, int wr, int wc, int fr, int fq) const {
        const int blk_col = wc * 32 + 8 * fq;
#pragma unroll
        for (int ai = 0; ai < 2; ++ai) { const int blk = ai * 2 + wr;
            if (fr == 0) {
#pragma unroll
                for (int n = 0; n < 2; ++n)
#pragma unroll
                    for (int j = 0; j < 4; ++j) xl[blk * 128 + blk_col + 4 * n + j] = acc[ai][0][0][n][j]; }
            if (fr == 15) {
#pragma unroll
                for (int n = 0; n < 2; ++n)
#pragma unroll
                    for (int j = 0; j < 4; ++j) xl[512 + blk * 128 + blk_col + 4 * n + j] = acc[ai][0][3][n][j]; } }
        asm volatile("s_waitcnt lgkmcnt(0)" ::: "memory"); __builtin_amdgcn_s_barrier(); asm volatile("" ::: "memory");
        const int acol0 = u.pn * 128 + blk_col;
        float w0[8], w1[8], w2[8], bb[8];
#pragma unroll
        for (int q = 0; q < 8; ++q) { w0[q] = fw[acol0 + q]; w1[q] = fw[DFF + acol0 + q]; w2[q] = fw[2 * DFF + acol0 + q]; bb[q] = fb[acol0 + q]; }
#pragma unroll
        for (int ai = 0; ai < 2; ++ai) { const int blk = ai * 2 + wr;
#pragma unroll
            for (int m = 0; m < 4; ++m) {
                const int rt = ai * HALF + wr * 64 + m * 16 + fr;
                float o[8];
#pragma unroll
                for (int n = 0; n < 2; ++n)
#pragma unroll
                    for (int j = 0; j < 4; ++j) { const int q = 4 * n + j; const float uc = acc[ai][0][m][n][j];
                        float pv, nx;
                        if (m > 0) pv = dpp_ror1(fr == 15 ? acc[ai][0][m > 0 ? m - 1 : 0][n][j] : uc);
                        else { pv = dpp_ror1(uc); const float t = (blk > 0 && fr == 0) ? xl[512 + (blk - 1) * 128 + blk_col + q] : 0.f; pv = fr == 0 ? t : pv; }
                        if (m < 3) nx = dpp_rol1(fr == 0 ? acc[ai][0][m < 3 ? m + 1 : 3][n][j] : uc);
                        else { nx = dpp_rol1(uc); const float t = (blk < 3 && fr == 15) ? xl[(blk + 1) * 128 + blk_col + q] : 0.f; nx = fr == 15 ? t : nx; }
                        o[q] = gelu_t(w0[q] * pv + w1[q] * uc + w2[q] * nx + bb[q]) * acc[ai][1][m][n][j]; }
                const bool edge = (ai == 0 && m == 0) ? (wr == 0 && fr <= 1) : ((ai == 1 && m == 3) ? (wr == 1 && fr >= 14) : false);
                if ((ai == 0 && m == 0) || (ai == 1 && m == 3)) {
                    if (rt != 0 && rt != 255) *(u32x4*)(ACTp + (size_t)(u.pm * BM + rt) * DFF + acol0) = pack8(o);
                    if (edge) { const int slot = rt <= 1 ? rt : rt - 252; float* sb = SB + ((size_t)u.pm * 6 + slot) * DFF + acol0;
                        *(f32x4*)sb = acc[ai][0][m][0]; *(f32x4*)(sb + 4) = acc[ai][0][m][1];
                        if (rt == 0 || rt == 255) { float* sv = SB + ((size_t)u.pm * 6 + (rt == 0 ? 4 : 5)) * DFF + acol0; *(f32x4*)sv = acc[ai][1][m][0]; *(f32x4*)(sv + 4) = acc[ai][1][m][1]; } }
                } else *(u32x4*)(ACTp + (size_t)(u.pm * BM + rt) * DFF + acol0) = pack8(o);
            } }
    }
};
struct EpiStore {
    static constexpr bool PERM = true;
    bf16_t* O; int ldc;
    __device__ __forceinline__ void operator()(AccRef acc, const Unit& u, int wr, int wc, int fr, int fq) const {
        const int colw = u.pn * BM + wc * 32 + 8 * fq;
#pragma unroll
        for (int ai = 0; ai < 2; ++ai)
#pragma unroll
            for (int m = 0; m < 4; ++m) { const int r = u.pm * BM + ai * HALF + wr * 64 + m * 16 + fr;
#pragma unroll
                for (int bj = 0; bj < 2; ++bj) *(u32x4*)(O + (size_t)r * ldc + bj * HALF + colw) = pack_acc(acc[ai][bj][m][0], acc[ai][bj][m][1]); }
    }
};
}

namespace att {
constexpr int AD = 128, NW = 8, QBLK = 32, KVBLK = 64;
constexpr float SCALE = 0.088388347648318440f;
constexpr float THR = 8.f;
constexpr int LDQ = 1024, LDK = 256, LDO = 1024;
constexpr size_t SHM_V = KVBLK * AD * 2, SHM_K = KVBLK * AD * 2, SHM_ATTN = 2 * SHM_V + 2 * SHM_K + NW * 64 * 4;
#define KSWZ(row, colB) ((row) * 256 + ((colB) ^ (((row) & 7) << 4)))
#define SBAR() __builtin_amdgcn_sched_barrier(0)
__device__ __forceinline__ int crow(int r, int hi) { return (r & 3) + 8 * (r >> 2) + 4 * hi; }
__device__ __forceinline__ void partialSM(f32x16& p0, f32x16& p1, float& m_reg, float& mn, float& alpha) {
  constexpr float C = SCALE * 1.4426950408889634f;
  float pmax = p0[0]; for (int r = 1; r < 16; ++r) pmax = fmaxf(pmax, p0[r]); for (int r = 0; r < 16; ++r) pmax = fmaxf(pmax, p1[r]);
  { auto rr = __builtin_amdgcn_permlane32_swap(__float_as_uint(pmax), __float_as_uint(pmax), false, false);
    pmax = fmaxf(__uint_as_float(rr[0]), __uint_as_float(rr[1])); }
  if (__builtin_expect(__all(pmax - m_reg <= THR / SCALE), 1)) { mn = m_reg; alpha = 1.f; }
  else { mn = fmaxf(m_reg, pmax); alpha = __builtin_amdgcn_exp2f((m_reg - mn) * C); m_reg = mn; }
  float mnC = -mn * C;
  for (int r = 0; r < 16; ++r) p0[r] = fmaf(p0[r], C, mnC); for (int r = 0; r < 16; ++r) p1[r] = fmaf(p1[r], C, mnC);
  for (int r = 0; r < 16; ++r) p0[r] = __builtin_amdgcn_exp2f(p0[r]);
}
__device__ __forceinline__ void finishSM(f32x16& p0, f32x16& p1, float alpha, float& l_reg, bf16x8& pa0, bf16x8& pa1, bf16x8& pa2, bf16x8& pa3) {
  for (int r = 0; r < 16; ++r) p1[r] = __builtin_amdgcn_exp2f(p1[r]);
  float ps = 0; for (int r = 0; r < 16; ++r) ps += p0[r]; for (int r = 0; r < 16; ++r) ps += p1[r];
  { auto rr = __builtin_amdgcn_permlane32_swap(__float_as_uint(ps), __float_as_uint(ps), false, false);
    ps = __uint_as_float(rr[0]) + __uint_as_float(rr[1]); }
  l_reg = l_reg * alpha + ps;
#define PK4(P, BASE, OUT) do { unsigned a0 = cvt_pk_bf16(P[BASE + 0], P[BASE + 1]), a1 = cvt_pk_bf16(P[BASE + 2], P[BASE + 3]);   \
    unsigned b0 = cvt_pk_bf16(P[BASE + 4], P[BASE + 5]), b1 = cvt_pk_bf16(P[BASE + 6], P[BASE + 7]);                              \
    auto r0 = __builtin_amdgcn_permlane32_swap(a0, b0, false, false); auto r1 = __builtin_amdgcn_permlane32_swap(a1, b1, false, false); \
    u32x4 w = {r0[0], r1[0], r0[1], r1[1]}; OUT = *reinterpret_cast<bf16x8*>(&w); } while (0)
  PK4(p0, 0, pa0); PK4(p0, 8, pa1); PK4(p1, 0, pa2); PK4(p1, 8, pa3);
#undef PK4
}
__device__ __forceinline__ void qkt(f32x16& p0, f32x16& p1, const bf16_t* Ks, const bf16x8* qr, int r32, int hi) {
  p0 = f32x16{}; p1 = f32x16{};
  for (int d0 = 0; d0 < 8; ++d0) { int cb = (d0 * 16 + hi * 8) * 2;
    bf16x8 b0 = *reinterpret_cast<const bf16x8*>((const char*)Ks + KSWZ(r32, cb));
    bf16x8 b1 = *reinterpret_cast<const bf16x8*>((const char*)Ks + KSWZ(32 + r32, cb));
    p0 = __builtin_amdgcn_mfma_f32_32x32x16_bf16(b0, qr[d0], p0, 0, 0, 0);
    p1 = __builtin_amdgcn_mfma_f32_32x32x16_bf16(b1, qr[d0], p1, 0, 0, 0); }
}
__device__ __forceinline__ int v_st(int k, int c) { const int kk = (k & ~0xC) | ((k & 4) << 1) | ((k & 8) >> 1); return ((kk >> 3) * 4 + (c >> 5)) * 512 + ((kk & 7) * 32 + (c & 31)) * 2; }
__device__ __forceinline__ int v_rd_base(int lane) { return ((lane & 3) << 3) | (((lane >> 2) & 3) << 6) | (((lane >> 4) & 1) << 5) | (((lane >> 5) & 1) << 8); }
constexpr int v_rd_off(int d0, int ks, int half) { return d0 * 512 + ks * 4096 + half * 2048; }
template <int OFF> __device__ __forceinline__ s16x4 tr_read(int vb) {
  s16x4 r; asm volatile("ds_read_b64_tr_b16 %0, %1 offset:%2" : "=&v"(r) : "v"(vb), "i"(OFF) : "memory"); return r;
}
template <int D0> __device__ __forceinline__ void pv_one(f32x16& od, int vb, bf16x8 pa0, bf16x8 pa1, bf16x8 pa2, bf16x8 pa3) {
  const s16x4 l0 = tr_read<v_rd_off(D0, 0, 0)>(vb), h0 = tr_read<v_rd_off(D0, 0, 1)>(vb), l1 = tr_read<v_rd_off(D0, 1, 0)>(vb), h1 = tr_read<v_rd_off(D0, 1, 1)>(vb);
  const s16x4 l2 = tr_read<v_rd_off(D0, 2, 0)>(vb), h2 = tr_read<v_rd_off(D0, 2, 1)>(vb), l3 = tr_read<v_rd_off(D0, 3, 0)>(vb), h3 = tr_read<v_rd_off(D0, 3, 1)>(vb);
  asm volatile("s_waitcnt lgkmcnt(0)" ::: "memory"); SBAR();
#define PK(L, H) (bf16x8){L[0], L[1], L[2], L[3], H[0], H[1], H[2], H[3]}
  od = __builtin_amdgcn_mfma_f32_32x32x16_bf16(pa0, PK(l0, h0), od, 0, 0, 0);
  od = __builtin_amdgcn_mfma_f32_32x32x16_bf16(pa1, PK(l1, h1), od, 0, 0, 0);
  od = __builtin_amdgcn_mfma_f32_32x32x16_bf16(pa2, PK(l2, h2), od, 0, 0, 0);
  od = __builtin_amdgcn_mfma_f32_32x32x16_bf16(pa3, PK(l3, h3), od, 0, 0, 0);
#undef PK
}
__device__ __forceinline__ void pv_d0(f32x16* o, int vb, bf16x8 pa0, bf16x8 pa1, bf16x8 pa2, bf16x8 pa3) {
  pv_one<0>(o[0], vb, pa0, pa1, pa2, pa3); pv_one<1>(o[1], vb, pa0, pa1, pa2, pa3); pv_one<2>(o[2], vb, pa0, pa1, pa2, pa3); pv_one<3>(o[3], vb, pa0, pa1, pa2, pa3);
}
__device__ __forceinline__ void attn_dense_body(const bf16_t* __restrict__ Qb, const bf16_t* __restrict__ Kh, const bf16_t* __restrict__ Vh,
                                                bf16_t* __restrict__ Ob, int seq, char* lds, const int tid, const int wid) {
  const int  lane = tid & 63, r32 = lane & 31, hi = lane >> 5;
  bf16_t* V_lds = (bf16_t*)lds; bf16_t* K_lds = (bf16_t*)(lds + 2 * SHM_V);
  float* ws = (float*)(lds + 2 * SHM_V + 2 * SHM_K) + wid * 64; float* li_l = ws; float* al_l = ws + 32;
  float m_reg = -1e30f, l_reg = 0; f32x16 o[4] = {}; bf16x8 qr[8];
  const bf16_t* Qw = Qb + (long)(wid * QBLK) * LDQ + (unsigned)(r32 * LDQ + hi * 8);
#pragma unroll
  for (int d0 = 0; d0 < 8; ++d0) qr[d0] = *reinterpret_cast<const bf16x8*>(Qw + d0 * 16);
  const int sr = tid >> 4, sc = (tid & 15) * 8, vst0 = v_st(sr, sc), vst1 = v_st(32 + sr, sc);
  const int vb0 = (int)(uintptr_t)V_lds + v_rd_base(lane);
  const unsigned so0 = (unsigned)(sr * LDK + sc), so1 = (unsigned)((32 + sr) * LDK + sc);
  struct { bf16x8 vs0, vs1, ks0, ks1; } sr_[2];
#define LD8(p) (*reinterpret_cast<const bf16x8*>(p))
#define SLOAD(i, k0) do { const bf16_t* Vt_ = Vh + (long)(k0) * LDK; const bf16_t* Kt_ = Kh + (long)(k0) * LDK; \
    sr_[i].vs0 = LD8(Vt_ + so0); sr_[i].vs1 = LD8(Vt_ + so1); sr_[i].ks0 = LD8(Kt_ + so0); sr_[i].ks1 = LD8(Kt_ + so1); } while (0)
#define SWRITE(b, i) do { *(bf16x8*)((char*)V_lds + (b) * SHM_V + vst0) = sr_[i].vs0;          \
    *(bf16x8*)((char*)V_lds + (b) * SHM_V + vst1) = sr_[i].vs1; int kc = sc * 2;               \
    *(bf16x8*)((char*)K_lds + (b) * SHM_K + KSWZ(sr, kc)) = sr_[i].ks0;                       \
    *(bf16x8*)((char*)K_lds + (b) * SHM_K + KSWZ(32 + sr, kc)) = sr_[i].ks1; } while (0)
#define SWAIT() asm volatile("s_waitcnt vmcnt(4)" ::: "memory")
#define RESC(a) do { if (__any((a) < 1.f)) { if (hi == 0) al_l[r32] = (a); asm volatile("s_waitcnt lgkmcnt(0)" ::: "memory"); \
    for (int d = 0; d < 4; ++d) for (int r = 0; r < 16; ++r) o[d][r] *= al_l[crow(r, hi)]; } } while (0)
  f32x16 pA0, pA1, pB0, pB1; float mnA, mnB, alA, alB; bf16x8 pa0, pa1, pa2, pa3; const int NT = seq / KVBLK;
  constexpr int SE = 0, SO = 1;
  SLOAD(SE, 0); asm volatile("s_waitcnt vmcnt(0)" ::: "memory"); SWRITE(0, SE); __syncthreads();
  qkt(pA0, pA1, K_lds, qr, r32, hi); partialSM(pA0, pA1, m_reg, mnA, alA);
  SLOAD(SO, KVBLK); if (2 < NT) SLOAD(SE, 2 * KVBLK);
  SWAIT(); SWRITE(1, SO); __syncthreads();
  for (int j = 1; j + 1 < NT; j += 2) {
    SBAR(); qkt(pB0, pB1, (bf16_t*)((char*)K_lds + SHM_K), qr, r32, hi);
    finishSM(pA0, pA1, alA, l_reg, pa0, pa1, pa2, pa3); SBAR();
    SLOAD(SO, (j + 2) * KVBLK); SBAR();
    pv_d0(o, vb0, pa0, pa1, pa2, pa3); partialSM(pB0, pB1, m_reg, mnB, alB);
    __syncthreads(); SWAIT(); SWRITE(0, SE);
    RESC(alB); __syncthreads();
    SBAR(); qkt(pA0, pA1, K_lds, qr, r32, hi);
    finishSM(pB0, pB1, alB, l_reg, pa0, pa1, pa2, pa3); SBAR();
    if (j + 3 < NT) SLOAD(SE, (j + 3) * KVBLK); SBAR();
    pv_d0(o, vb0 + (int)SHM_V, pa0, pa1, pa2, pa3); partialSM(pA0, pA1, m_reg, mnA, alA);
    __syncthreads(); SWAIT(); SWRITE(1, SO);
    RESC(alA); __syncthreads();
  }
  SBAR(); qkt(pB0, pB1, (bf16_t*)((char*)K_lds + SHM_K), qr, r32, hi);
  finishSM(pA0, pA1, alA, l_reg, pa0, pa1, pa2, pa3); SBAR();
  pv_d0(o, vb0, pa0, pa1, pa2, pa3); partialSM(pB0, pB1, m_reg, mnB, alB);
  __syncthreads(); RESC(alB);
  finishSM(pB0, pB1, alB, l_reg, pa0, pa1, pa2, pa3); SBAR();
  pv_d0(o, vb0 + (int)SHM_V, pa0, pa1, pa2, pa3);
  if (hi == 0) li_l[r32] = l_reg; asm volatile("s_waitcnt lgkmcnt(0)" ::: "memory");
  float rli[16];
#pragma unroll
  for (int r = 0; r < 16; ++r) rli[r] = __builtin_amdgcn_rcpf(li_l[crow(r, hi)]);
  bf16_t* Ow = Ob + (long)(wid * QBLK) * LDO;
  int lane_e = lane; asm volatile("" : "+v"(lane_e)); const int r32e = lane_e & 31, hie = lane_e >> 5;
#pragma unroll
  for (int r = 0; r < 16; ++r) { const unsigned orow = (unsigned)crow(r, hie);
    for (int d0 = 0; d0 < 4; ++d0) Ow[orow * (unsigned)LDO + (unsigned)(d0 * 32 + r32e)] = (bf16_t)(cvt_pk_bf16(o[d0][r] * rli[r], 0.f) & 0xffffu); }
  __syncthreads();
#undef LD8
#undef SLOAD
#undef SWRITE
#undef SWAIT
#undef RESC
}
}

struct Args { const float* in[30]; float* out; unsigned char* ws; int ph_lo, ph_hi; };

__device__ __forceinline__ void transpose_item(const float* W, int K, int N, bf16_t* WT, int k0, int n0, int dst_row0, LAS float* scr, int lane) {
    float wv[32];
#pragma unroll
    for (int i = 0; i < 32; ++i) { const int kk = 2 * i + (lane >> 5); wv[i] = W[(size_t)(k0 + kk) * N + n0 + (lane & 31)]; }
#pragma unroll
    for (int i = 0; i < 32; ++i) { const int kk = 2 * i + (lane >> 5); scr[kk * 33 + (lane & 31)] = wv[i]; }
    asm volatile("s_waitcnt lgkmcnt(0)" ::: "memory");
    const int c = lane & 7;
#pragma unroll
    for (int j = 0; j < 4; ++j) { const int n = (lane >> 3) + 8 * j; const LAS float* s = scr + (8 * c) * 33 + n;
        u32x4 o; o.x = cvt_pk_bf16(s[0 * 33], s[1 * 33]); o.y = cvt_pk_bf16(s[2 * 33], s[3 * 33]); o.z = cvt_pk_bf16(s[4 * 33], s[5 * 33]); o.w = cvt_pk_bf16(s[6 * 33], s[7 * 33]);
        *(u32x4*)(WT + (size_t)(dst_row0 + n) * K + k0 + 8 * c) = o; }
    asm volatile("s_waitcnt lgkmcnt(0)" ::: "memory");
}
__device__ __forceinline__ int up_row(int n0) { return n0 < DFF ? (n0 >> 7) * 256 + (n0 & 127) : ((n0 - DFF) >> 7) * 256 + 128 + ((n0 - DFF) & 127); }
__device__ __forceinline__ int glu_row(int n0) { return n0 < 1024 ? (n0 >> 7) * 256 + (n0 & 127) : ((n0 - 1024) >> 7) * 256 + 128 + ((n0 - 1024) & 127); }

__device__ __forceinline__ void ld_row(f32x4 (&v)[4], const float* src, int lane) {
#pragma unroll
    for (int q = 0; q < 4; ++q) v[q] = *(const f32x4*)(src + lane * 4 + 256 * q);
}
__device__ __forceinline__ void ln_stats(f32x4 (&v)[4], float& rstd) {
    float s = 0.f;
#pragma unroll
    for (int q = 0; q < 4; ++q) s += (v[q][0] + v[q][1]) + (v[q][2] + v[q][3]);
    const float mean = wave_sum(s) * (1.f / D); float s2 = 0.f;
#pragma unroll
    for (int q = 0; q < 4; ++q) { v[q] = v[q] - mean; s2 += (v[q][0] * v[q][0] + v[q][1] * v[q][1]) + (v[q][2] * v[q][2] + v[q][3] * v[q][3]); }
    rstd = rsqrtf(wave_sum(s2) * (1.f / D) + LN_EPS);
}
__device__ __forceinline__ void ln_mod_regs(f32x4 (&v)[4], const float* shift, const float* scale, bf16_t* dst, int lane, bool ok) {
    float rstd; ln_stats(v, rstd);
    if (ok) {
#pragma unroll
        for (int q = 0; q < 4; ++q) { const int c = lane * 4 + 256 * q; const f32x4 sc = *(const f32x4*)(scale + c), sh = *(const f32x4*)(shift + c);
            const f32x4 y = v[q] * rstd * (sc + 1.0f) + sh; u32x2 w; w.x = cvt_pk_bf16(y[0], y[1]); w.y = cvt_pk_bf16(y[2], y[3]); *(u32x2*)(dst + c) = w; }
    }
}
__device__ __forceinline__ void post_norm_regs(f32x4 (&v)[4], float* rx, const float* lg, const float* lb, bool do_mod, const float* shift, const float* scale, bf16_t* dst, int lane, bool ok) {
    float rstd; ln_stats(v, rstd);
#pragma unroll
    for (int q = 0; q < 4; ++q) { const int c = lane * 4 + 256 * q; v[q] = v[q] * rstd * *(const f32x4*)(lg + c) + *(const f32x4*)(lb + c); if (ok) *(f32x4*)(rx + c) = v[q]; }
    if (do_mod) ln_mod_regs(v, shift, scale, dst, lane, ok);
}

#define XB_TMO      128
#define XB_XCNT(j)  (256  + 64 * (j))
#define XB_XSUB(j)  (1280 + 64 * (j))
#define XB_XGEN(j)  (2304 + 64 * (j))
#define XB_TOP      3328
#define XB_TOPGEN   3392
#define XCD_BAR_WORDS 3456
#define XB_SPIN_CAP (1u << 18)

__device__ __forceinline__ unsigned xb_ld(unsigned* p)              { return __hip_atomic_load(p, __ATOMIC_RELAXED, __HIP_MEMORY_SCOPE_AGENT); }
__device__ __forceinline__ unsigned xb_add(unsigned* p, unsigned v) { return __hip_atomic_fetch_add(p, v, __ATOMIC_RELAXED, __HIP_MEMORY_SCOPE_AGENT); }
__device__ __forceinline__ unsigned xb_xcc_id() { return (unsigned)__builtin_amdgcn_s_getreg((3 << 11) | 20) & 0xFu; }
#define XB_SPIN(cond, bar) do { unsigned _sp = 0; while (cond) { __builtin_amdgcn_s_sleep(1); \
    if ((++_sp & 255u) == 0u) { if (xb_ld(&(bar)[XB_TMO])) break; if (_sp > XB_SPIN_CAP) { atomicAdd(&(bar)[XB_TMO], 1u); break; } } } } while (0)

struct XcdBarrier {
    unsigned* bar; unsigned x;
    volatile LAS unsigned* st;
};

__device__ __forceinline__ XcdBarrier xcd_barrier_post(unsigned* bar, volatile LAS unsigned* st) {
    XcdBarrier b; b.bar = bar; b.x = xb_xcc_id(); b.st = st;
    if (threadIdx.x == 0) (void)xb_add(&bar[XB_XCNT(b.x)], 1u);
    return b;
}
__device__ __forceinline__ void xcd_barrier_complete(unsigned* bar, unsigned x, unsigned& nloc, unsigned& nx) {
    const unsigned G = gridDim.x * gridDim.y * gridDim.z;
    unsigned sum, cnt, mine, sp = 0u;
    for (;;) {
        sum = 0u; cnt = 0u; mine = 0u;
#pragma unroll
        for (unsigned j = 0; j < 16; ++j) { const unsigned c = xb_ld(&bar[XB_XCNT(j)]); sum += c; cnt += (c > 0u) ? 1u : 0u; mine = (j == x) ? c : mine; }
        if (sum == G) break;
        __builtin_amdgcn_s_sleep(1);
        if ((++sp & 255u) == 0u) { if (xb_ld(&bar[XB_TMO])) break; if (sp > XB_SPIN_CAP) { atomicAdd(&bar[XB_TMO], 1u); break; } }
    }
    nloc = mine > 0u ? mine : 1u; nx = cnt > 0u ? cnt : 1u;
}

__device__ __forceinline__ void xcd_barrier(const XcdBarrier& b) {
    asm volatile("s_waitcnt vmcnt(0)" ::: "memory");
    __syncthreads();
    if (threadIdx.x == 0) {
        unsigned* bar = b.bar;
        __builtin_amdgcn_s_waitcnt(0);
        unsigned nloc = b.st[0], nx = b.st[1];
        if (nloc == 0u) { xcd_barrier_complete(bar, b.x, nloc, nx); b.st[0] = nloc; b.st[1] = nx; }
        const unsigned old = xb_add(&bar[XB_XSUB(b.x)], 1u);
        const unsigned gen = old / nloc;
        if (old + 1u == (gen + 1u) * nloc) {
            __builtin_amdgcn_fence(__ATOMIC_RELEASE, "agent");
            asm volatile("s_waitcnt vmcnt(0)" ::: "memory");
            const unsigned og = xb_add(&bar[XB_TOP], 1u);
            const unsigned tg = og / nx;
            if (og + 1u == (tg + 1u) * nx) xb_add(&bar[XB_TOPGEN], 1u);
            else XB_SPIN(xb_ld(&bar[XB_TOPGEN]) == tg, bar);
            __builtin_amdgcn_fence(__ATOMIC_ACQUIRE, "agent");
            xb_add(&bar[XB_XGEN(b.x)], 1u);
            asm volatile("s_waitcnt vmcnt(0)" ::: "memory");
        } else {
            XB_SPIN(xb_ld(&bar[XB_XGEN(b.x)]) == gen, bar);
            __builtin_amdgcn_fence(__ATOMIC_ACQUIRE, "agent");
            asm volatile("s_waitcnt vmcnt(0)" ::: "memory");
        }
    }
    __syncthreads();
}


    typedef const __attribute__((address_space(4))) unsigned char* kptr_t;
#define PH_LOCALS \
    unsigned lz_ = 0u; asm volatile("" : "+v"(lz_)); const int lane = (int)__builtin_amdgcn_mbcnt_hi(~0u, __builtin_amdgcn_mbcnt_lo(~0u, lz_)); \
    int G = G0; asm volatile("" : "+s"(G)); int bx = bx0; asm volatile("" : "+s"(bx)); int wave = wave0; asm volatile("" : "+s"(wave)); \
    const int NGW = G * 8; const long NGT = (long)G * 512; (void)NGW; (void)NGT; const int tid = wave * 64 + lane; \
    const int gw = bx * 8 + wave; const long gt = (long)bx * 512 + tid; (void)gw; (void)gt; (void)lane; \
    __attribute__((address_space(1))) unsigned char* ws_ = (__attribute__((address_space(1))) unsigned char*)a.ws; asm volatile("" : "+s"(ws_)); unsigned char* const ws = (unsigned char*)ws_; \
    kptr_t kp = (kptr_t)__builtin_amdgcn_kernarg_segment_ptr(); asm volatile("" : "+s"(kp)); (void)kp;
#define INP(k) ((const float*)(*(const __attribute__((address_space(1))) float* const __attribute__((address_space(4)))*)(kp + 8 * (k))))
#define MODV ((float*)WSP(WS_MODV))
#define ROPEC ((float*)WSP(WS_ROPE))
#define ROPES (ROPEC + 2048 * 64)
#define LP ((f32x2*)WSP(WS_LP))
#define KT ((float*)WSP(WS_KT))
#define EBm ((bf16_t*)WSP(WS_EB))
#define TRm ((bf16_t*)WSP(WS_TR))
#define CTXRES ((float*)WSP(WS_CTXRES))
#define WB ((bf16_t*)WSP(WS_WB))
#define Hb ((bf16_t*)WSP(WS_H + (size_t)hf * 36 * MiB))
#define HbF ((bf16_t*)WSP(WS_H))
#define KB ((bf16_t*)WSP(WS_KB))
#define VB ((bf16_t*)WSP(WS_VB))
#define QO ((bf16_t*)WSP(WS_QO))
#define AX ((bf16_t*)WSP(WS_AX))
#define BGb ((bf16_t*)WSP(WS_BG))
#define CGb ((bf16_t*)WSP(WS_CG))
#define GT ((bf16_t*)WSP(WS_GT))
#define A2 ((bf16_t*)WSP(WS_A2))
#define E2 ((bf16_t*)WSP(WS_E2))
#define MG ((bf16_t*)WSP(WS_MG))
#define O2 ((bf16_t*)WSP(WS_O2))
#define CV ((bf16_t*)WSP(WS_H + (size_t)hf * 36 * MiB))
#define Yb ((bf16_t*)WSP(WS_H + (size_t)hf * 36 * MiB + 18 * MiB))
#define UV ((bf16_t*)WSP(WS_UV))
#define ACT ((bf16_t*)WSP(WS_ACT))
#define SBF ((float*)WSP(WS_FSB))
#define ACTF ((bf16_t*)WSP(WS_FACT))
#define x_in INP(0)
#define c_in INP(1)
#define ctx_in INP(2)
#define cctx_in INP(3)
#define modL (MODV + (size_t)layer * 17 * 6144)
#define EBl (EBm + (size_t)layer * 32 * 256 * 256)
#define TRl (TRm + (size_t)layer * 32 * 256 * 512)
#define resL0 ((layer == 0 ? x_in : (const float*)a.out) + (size_t)hf * ML * D)
#define resC0 ((layer == 0 ? ctx_in : (const float*)CTXRES) + (size_t)hf * MC * D)
#define outL (a.out + (size_t)hf * ML * D)
#define outC (CTXRES + (size_t)hf * MC * D)

#define RUN() (ph >= a.ph_lo && ph < a.ph_hi)
#define RUNP(id) for (int rep_ = 0; rep_ < (((PROBE_MASK >> (id)) & 1) ? 2 : 1); ++rep_, __syncthreads()) if (RUN())
#define SEAM() do { ++ph; if (ph > a.ph_lo && ph < a.ph_hi) xcd_barrier(xbar); } while (0)
template <int layer>
__device__ __forceinline__ void convert_weights(const Args& a, LAS unsigned char* lds, const int G0, const int bx0, const int wave0) {
    { PH_LOCALS
                    LAS float* scr = (LAS float*)(lds + wave * 16384);
                    constexpr int I_IN = 16 * (INC / 32), I_CO = 8 * 32, I_GLU = 8 * 64, I_AO = 16 * 32, I_O = 16 * 32, I_UP = 16 * (2 * DFF / 32), I_DN = (DFF / 64) * 32;
                    constexpr int NIT = I_IN + I_CO + I_GLU + I_AO + I_O + I_UP + I_DN;
                    for (int it = gw; it < NIT; it += NGW) {
                        int r = it; const float* W; int K, N; bf16_t* WT; bool glu = false, upw = false;
                        if (r < I_IN) { W = INP(6) + (size_t)layer * D * INC; K = D; N = INC; WT = (bf16_t*)(WSP(WS_WB + WO_IN * 2)); }
                        else if ((r -= I_IN) < I_CO) { W = INP(8) + (size_t)layer * 512 * D; K = 512; N = D; WT = (bf16_t*)(WSP(WS_WB + WO_CO * 2)); }
                        else if ((r -= I_CO) < I_GLU) { W = INP(17) + (size_t)layer * 512 * 2048; K = 512; N = 2048; WT = (bf16_t*)(WSP(WS_WB + WO_GLU * 2)); glu = true; }
                        else if ((r -= I_GLU) < I_AO) { W = INP(20) + (size_t)layer * D * D; K = D; N = D; WT = (bf16_t*)(WSP(WS_WB + WO_AO * 2)); }
                        else if ((r -= I_AO) < I_O) { W = INP(21) + (size_t)layer * D * D; K = D; N = D; WT = (bf16_t*)(WSP(WS_WB + WO_O * 2)); }
                        else if ((r -= I_O) < I_UP) { W = INP(24) + (size_t)layer * D * 2 * DFF; K = D; N = 2 * DFF; WT = (bf16_t*)(WSP(WS_WB + WO_UP * 2)); upw = true; }
                        else { r -= I_UP; W = INP(27) + (size_t)layer * DFF * D; K = DFF; N = D; WT = (bf16_t*)(WSP(WS_WB + WO_DN * 2)); }
                        const int nblk = N / 32, kb = r / nblk, nb = r % nblk, n0 = 32 * nb;
                        transpose_item(W, K, N, WT, 64 * kb, n0, glu ? glu_row(n0) : (upw ? up_row(n0) : n0), scr, lane);
                    }
                    } { PH_LOCALS
                    for (long i = gt; i < 32L * 256 * 32; i += NGT) {
                        const int k8 = (int)(i & 31), n = (int)((i >> 5) & 255), g = (int)(i >> 13);
                        const int tau = n >> 4, h = n & 15, tp = k8 >> 1, h0 = (k8 & 1) * 8; float o[8];
                        const float* kf = KT + ((((size_t)layer * 2 + 0) * 32 + g) * 16) * 256; const float* kr = KT + ((((size_t)layer * 2 + 1) * 32 + g) * 16) * 256;
#pragma unroll
                        for (int j = 0; j < 8; ++j) { const int hp = h0 + j; float v = 0.f;
                            if (tp <= tau) v += kf[(tau - tp) * 256 + h * 16 + hp];
                            if (tp >= tau) v += kr[(tp - tau) * 256 + h * 16 + hp];
                            if (tp == tau && hp == h) v += INP(16)[layer * 512 + g * 16 + h];
                            o[j] = v; }
                        *(u32x4*)(TRm + (((size_t)layer * 32 + g) * 256 + n) * 512 + k8 * 8) = pack8(o);
                    } }
}
__device__ __forceinline__ int hrow_of(int m) {
    if (m < NBATCH * SEQ) { const int b = m >> 11, t = m & 2047; return (b >> 3) * MH + (b & 7) * SEQ + t; }
    const int mc = m - NBATCH * SEQ, b = mc >> 8, t = mc & 255; return (b >> 3) * MH + ML + (b & 7) * CTX + t;
}
template <int layer, int hf>
__device__ __forceinline__ void g_phase(const Args& a, LAS unsigned char* lds, const int G0, const int bx0, const int wave0) {
    constexpr bool last = (layer == DEPTH - 1);
    { PH_LOCALS
        pg8::Gemm g{MG, (bf16_t*)(WSP(WS_WB + WO_O * 2))}; pg8::Order S; S.init((last ? ML : MH) / 256, 4, G, hf == 0 ? G - 1 - bx : bx);
        pg8::EpiRes E{resL0, resC0, outL, outC, modL + 2048, hf * HBT, ML}; pg8::gemm_phase<D, D, D>(lds, g, S, E, tid);
    }
}
template <int layer, int hf>
__device__ __forceinline__ void layer_half(const Args& a, LAS unsigned char* lds, unsigned char* lds_raw, int& ph, const XcdBarrier& xbar, const int G0, const int bx0, const int wave0) {
    constexpr bool last = (layer == DEPTH - 1);
            RUNP(3) {
                if (hf == 1) g_phase<layer, 0>(a, lds, G0, bx0, wave0);
                PH_LOCALS
                pg8::Gemm g{Hb, (bf16_t*)(WSP(WS_WB + WO_IN * 2))}; pg8::Order S;
                if (!last) S.init(MH / 256, INC / 256, G, bx); else { S.init(ML / 256, INC / 256, G, bx); S.xM0 = ML / 256; S.xNN = 4; S.xcnt = (MC / 256) * 4; }
                pg8::EpiIn E{ws, INP(18) + layer * 128, INP(19) + layer * 128, (LAS float*)(lds + 131072 + 1024)};
                pg8::gemm_phase<D, D, D>(lds, g, S, E, tid);
            }
            SEAM();
            RUNP(4) {
                for (int L = bx0; L < 256; L += G0) {
                    const int g = L >> 3, bl = L & 7;
                    { PH_LOCALS pg8::Gemm g1{A2, EBl}; pg8::OneUnit S{L, g}; pg8::EpiSsm1 E{E2}; pg8::gemm_phase<512, 256, 256>(lds, g1, S, E, tid); }
                    asm volatile("s_waitcnt vmcnt(0)" ::: "memory");
                    { PH_LOCALS
                    if (wave < 2) { const int d = wave, p = lane;
                        unsigned* base = (unsigned*)(A2 + ((size_t)(g * A2R + bl * 256) * 512 + 256 + d * 128 + p * 2));
                        const unsigned* ebase = (const unsigned*)(E2 + ((size_t)(g * A2R + bl * 256) * 256 + d * 128 + p * 2));
                        const f32x2 l16 = LP[((((size_t)layer * 2 + d) * 32 + g) * 64 + p) * 18 + 16];
                        float sr = 0.f, si = 0.f;
#pragma unroll 1
                        for (int i0 = 0; i0 < NCH; i0 += 48) {
                            unsigned e[48];
#pragma unroll
                            for (int j = 0; j < 48; ++j) { const int i = i0 + j; const int c = d == 0 ? i : (i < 16 ? 15 - i : 159 - i); e[j] = ebase[(size_t)c * 128]; }
#pragma unroll
                            for (int j = 0; j < 48; ++j) { const int i = i0 + j; const int c = d == 0 ? i : (i < 16 ? 15 - i : 159 - i);
                                base[(size_t)c * 256] = cvt_pk_bf16(sr, si);
                                const float er = bflo(e[j]), ei = bfhi(e[j]); const float nr = l16.x * sr - l16.y * si + er, ni = l16.x * si + l16.y * sr + ei; sr = nr; si = ni; }
                        }
                    }
                    }
                    asm volatile("s_waitcnt vmcnt(0)" ::: "memory"); __syncthreads();
                    asm volatile("s_waitcnt vmcnt(0)" ::: "memory");
                    { PH_LOCALS pg8::Gemm g2{A2, TRl}; pg8::OneUnit S{L, g}; pg8::EpiSsm2 E{Yb}; pg8::gemm_phase<512, 512, 512>(lds, g2, S, E, tid); }
                }
                { PH_LOCALS
                const long ncv = (long)(last ? ML : MH) * 64; const float* cw = INP(7) + layer * 3 * 512;
                for (long it0 = gt; it0 < ncv; it0 += 3 * NGT) {
                    u32x4 rc[3][3], ra[3][3], rb[3]; bool ok[3], hasm[3], hasp[3]; size_t offs[3]; int cc[3];
#pragma unroll
                    for (int j = 0; j < 3; ++j) { const long it = it0 + j * NGT; ok[j] = it < ncv; const long itc = ok[j] ? it : it0;
                        const int m = (int)(itc >> 6), c0 = (int)(itc & 63) * 8; int t, tl; if (m < ML) { t = m & 2047; tl = 2047; } else { t = (m - ML) & 255; tl = 255; }
                        hasm[j] = t > 0; hasp[j] = t < tl; const size_t off = (size_t)m * 512 + c0; offs[j] = off; cc[j] = c0;
                        const size_t om = hasm[j] ? off - 512 : off, op = hasp[j] ? off + 512 : off;
                        rc[j][0] = *(const u32x4*)(CGb + om); ra[j][0] = *(const u32x4*)(AX + om); rc[j][1] = *(const u32x4*)(CGb + off); ra[j][1] = *(const u32x4*)(AX + off);
                        rc[j][2] = *(const u32x4*)(CGb + op); ra[j][2] = *(const u32x4*)(AX + op); rb[j] = *(const u32x4*)(BGb + off); }
#pragma unroll
                    for (int j = 0; j < 3; ++j) { float t1[8], t2[8], bg[8], o[8]; const int c0 = cc[j]; const float fm = hasm[j] ? 1.f : 0.f, fp = hasp[j] ? 1.f : 0.f;
#pragma unroll
                        for (int q = 0; q < 8; ++q) o[q] = 0.f;
#pragma unroll
                        for (int k = 0; k < 3; ++k) { unpack8(rc[j][k], t1); unpack8(ra[j][k], t2); const float f = k == 0 ? fm : (k == 2 ? fp : 1.f);
#pragma unroll
                            for (int q = 0; q < 8; ++q) o[q] += cw[k * 512 + c0 + q] * (t1[q] * t2[q] * f); }
                        unpack8(rb[j], bg);
#pragma unroll
                        for (int q = 0; q < 8; ++q) o[q] *= bg[q];
                        if (ok[j]) *(u32x4*)(CV + offs[j]) = pack8(o); }
                } }
            }
            RUNP(5) {
                { PH_LOCALS
                const int v = (G % 8 == 0) ? (bx % 8) * (G / 8) + bx / 8 : bx;
                const int nun = 512 + (last ? 0 : 64);
                for (int un = v; un < nun; un += G) {
                    if (un < 512) { const int pr = un >> 5, w = un & 31, bl = pr >> 1, kvh = pr & 1, h = kvh * 4 + (w >> 3), qb = w & 7;
                        bf16_t* Qb = QO + (size_t)(bl * 2048 + qb * 256) * 1024 + h * 128;
                        att::attn_dense_body(Qb, KB + (size_t)bl * SEQA * 256 + kvh * 128, VB + (size_t)bl * SEQA * 256 + kvh * 128, O2 + (Qb - QO), SEQA, (char*)lds_raw, tid, wave);
                    } else { const int w = un - 512, bl = w >> 3, h = w & 7, kvh = h >> 2;
                        bf16_t* Qb = QO + (size_t)(ML + bl * 256) * 1024 + h * 128;
                        att::attn_dense_body(Qb, KB + (size_t)bl * SEQA * 256 + kvh * 128, VB + (size_t)bl * SEQA * 256 + kvh * 128, O2 + (Qb - QO), CTX, (char*)lds_raw, tid, wave);
                    }
                } }
            }
            SEAM();
            RUNP(7) {
                const int nMm = (last ? ML : MH) / 256;
                { PH_LOCALS pg8::Gemm g{CV, (bf16_t*)(WSP(WS_WB + WO_CO * 2))}; pg8::Order S; S.init(nMm, 4, G, bx); pg8::EpiMerge<0> E{ws}; pg8::gemm_phase<512, 512, 512>(lds, g, S, E, tid); }
                asm volatile("s_waitcnt vmcnt(0)" ::: "memory"); asm volatile("s_waitcnt vmcnt(0)" ::: "memory"); __syncthreads();
                { PH_LOCALS pg8::Gemm g{Yb, (bf16_t*)(WSP(WS_WB + WO_GLU * 2))}; pg8::Order S; S.init(nMm, 4, G, bx); S.sub = 2; pg8::EpiMerge<1> E{ws}; pg8::gemm_phase<512, 512, 512>(lds, g, S, E, tid); }
                asm volatile("s_waitcnt vmcnt(0)" ::: "memory"); asm volatile("s_waitcnt vmcnt(0)" ::: "memory"); __syncthreads();
                { PH_LOCALS pg8::Gemm g{O2, (bf16_t*)(WSP(WS_WB + WO_AO * 2))}; pg8::Order S; S.init(nMm, 4, G, bx); pg8::EpiMerge<2> E{ws}; pg8::gemm_phase<D, D, D>(lds, g, S, E, tid); }
            }
            SEAM();
            if (hf == 1) {
            RUNP(8) { g_phase<layer, 1>(a, lds, G0, bx0, wave0); }
            SEAM();
            }
}

constexpr int FML = NBATCH * SEQ, FMC = NBATCH * CTX, FMH = FML + FMC;
template <int layer>
__device__ __forceinline__ void ffn_full(const Args& a, LAS unsigned char* lds, unsigned char* lds_raw, int& ph, const XcdBarrier& xbar, const int G0, const int bx0, const int wave0) {
    constexpr bool last = (layer == DEPTH - 1);
            RUNP(9) { PH_LOCALS
                const float* lg = INP(22) + layer * D; const float* lb = INP(23) + layer * D;
                constexpr int NR = last ? FML : FMH;
                for (int mb = gw; mb < NR; mb += 4 * NGW) {
                    f32x4 v[4][4]; int mm[4]; bool ok[4];
#pragma unroll
                    for (int j = 0; j < 4; ++j) { const int m = mb + j * NGW; ok[j] = m < NR; mm[j] = ok[j] ? m : mb;
                        ld_row(v[j], mm[j] < FML ? a.out + (size_t)mm[j] * D : CTXRES + (size_t)(mm[j] - FML) * D, lane); }
#pragma unroll
                    for (int j = 0; j < 4; ++j) { const bool lat = mm[j] < FML; float* rx = lat ? a.out + (size_t)mm[j] * D : CTXRES + (size_t)(mm[j] - FML) * D;
                        const float* mv = modL + (size_t)(lat ? (mm[j] >> 11) : 16) * 6144;
                        post_norm_regs(v[j], rx, lg, lb, true, mv + 3072, mv + 4096, HbF + (size_t)mm[j] * D, lane, ok[j]); }
                }
            }
            SEAM();
            RUNP(10) { PH_LOCALS pg8::Gemm g{HbF, (bf16_t*)(WSP(WS_WB + WO_UP * 2))}; pg8::Order S; S.init((last ? FML : FMH) / 256, 2 * DFF / 256, G, bx);
                pg8::EpiUp E{ACTF, SBF, INP(25) + (size_t)layer * 3 * DFF, INP(26) + (size_t)layer * DFF, (LAS float*)(lds + 131072 + 1024)}; pg8::gemm_phase<D, D, D>(lds, g, S, E, tid); }
            SEAM();
            RUNP(12) {
                { PH_LOCALS
                pg8::Order S; S.init((last ? FML : FMH) / 256, 4, G, bx); pg8::Unit u;
                const float* fw = INP(25) + (size_t)layer * 3 * DFF; const float* fb = INP(26) + (size_t)layer * DFF;
                for (int i = 0; S.next(i, u); ++i) {
                    const int pm = u.pm; const bool lat = pm < FML / 256; const bool seq_first = lat ? (pm & 7) == 0 : true, seq_last = lat ? (pm & 7) == 7 : true;
                    const float* sb = SBF + (size_t)pm * 6 * DFF;
#pragma unroll
                    for (int it_ = 0; it_ < (2 * DFF) / 512; ++it_) { const int idx = tid + it_ * 512; const int which = idx >= DFF ? 1 : 0, c = idx - which * DFF;
                        float pv, uc, nx, vv;
                        if (which == 0) { pv = seq_first ? 0.f : sb[-3 * DFF + c]; uc = sb[c]; nx = sb[DFF + c]; vv = sb[4 * DFF + c]; }
                        else { pv = sb[2 * DFF + c]; uc = sb[3 * DFF + c]; nx = seq_last ? 0.f : sb[6 * DFF + c]; vv = sb[5 * DFF + c]; }
                        const float o = gelu_t(fw[c] * pv + fw[DFF + c] * uc + fw[2 * DFF + c] * nx + fb[c]) * vv;
                        ACTF[(size_t)(pm * 256 + (which ? 255 : 0)) * DFF + c] = (bf16_t)(cvt_pk_bf16(o, 0.f) & 0xffffu); }
                }
                asm volatile("s_waitcnt vmcnt(0)" ::: "memory"); __syncthreads(); }
                { PH_LOCALS
                pg8::Gemm g{ACTF, (bf16_t*)(WSP(WS_WB + WO_DN * 2))}; pg8::Order S; S.init((last ? FML : FMH) / 256, 4, G, bx);
                pg8::EpiRes E{a.out, CTXRES, a.out, CTXRES, modL + 5120, 0, FML}; pg8::gemm_phase<DFF, DFF, DFF>(lds, g, S, E, tid); }
            }
            SEAM();
            RUNP(13) {
                if (!last) convert_weights<layer + 1>(a, lds, G0, bx0, wave0);
                { PH_LOCALS
                const float* lg = INP(28) + layer * D; const float* lb = INP(29) + layer * D;
                const float* modN = MODV + (size_t)(last ? layer : layer + 1) * 17 * 6144;
                constexpr int NR = last ? FML : FMH;
                for (int mb = gw; mb < NR; mb += 4 * NGW) {
                    f32x4 v[4][4]; int mm[4]; bool ok[4];
#pragma unroll
                    for (int j = 0; j < 4; ++j) { const int m = mb + j * NGW; ok[j] = m < NR; mm[j] = ok[j] ? m : mb;
                        ld_row(v[j], mm[j] < FML ? a.out + (size_t)mm[j] * D : CTXRES + (size_t)(mm[j] - FML) * D, lane); }
#pragma unroll
                    for (int j = 0; j < 4; ++j) { const bool lat = mm[j] < FML; float* rx = lat ? a.out + (size_t)mm[j] * D : CTXRES + (size_t)(mm[j] - FML) * D;
                        const float* mv = modN + (size_t)(lat ? (mm[j] >> 11) : 16) * 6144;
                        post_norm_regs(v[j], rx, lg, lb, !last, mv, mv + 1024, HbF + (size_t)hrow_of(mm[j]) * D, lane, ok[j]); }
                } }
            }
            SEAM();
}

__global__ void __launch_bounds__(512) mega_fwd(Args a) {
    extern __shared__ __attribute__((aligned(16))) unsigned char lds_raw[];
    LAS unsigned char* lds = (LAS unsigned char*)lds_raw;
    cg::grid_group grid = cg::this_grid();
    const int G0 = gridDim.x, bx0 = blockIdx.x, wave0 = __builtin_amdgcn_readfirstlane(threadIdx.x >> 6);
    int ph = 0;
    if (blockIdx.x == 0) for (int i = threadIdx.x; i < XCD_BAR_WORDS; i += 512) __hip_atomic_store((unsigned*)a.ws + i, 0u, __ATOMIC_RELAXED, __HIP_MEMORY_SCOPE_AGENT);
    if (threadIdx.x < 64) ((volatile LAS unsigned*)(lds + 131072))[threadIdx.x] = 0u;
    __syncthreads();

    RUNP(0) {
        { PH_LOCALS
        LAS float* sl = (LAS float*)lds;
        LAS float* red = (LAS float*)(lds + 17 * 1024 * 4);
        if (bx < 2 * 96) {
            for (int i = tid; i < 17 * 1024; i += 512) { const int j = i >> 10, k = i & 1023; const float v = j < 16 ? c_in[j * 1024 + k] : cctx_in[k]; sl[i] = v * sigm(v); }
            __syncthreads();
            for (int it = bx; it < 2 * 96; it += G) {
                const int layer = it / 96, n = (it % 96) * 64 + lane;
                const float* W = INP(4) + (size_t)layer * D * 6144;
                float acc[17];
#pragma unroll
                for (int j = 0; j < 17; ++j) acc[j] = 0.f;
                for (int k = wave * 128; k < wave * 128 + 128; ++k) { const float w = W[(size_t)k * 6144 + n];
#pragma unroll
                    for (int j = 0; j < 17; ++j) acc[j] += sl[j * 1024 + k] * w; }
#pragma unroll
                for (int j = 0; j < 17; ++j) red[(wave * 17 + j) * 64 + lane] = acc[j];
                __syncthreads();
                for (int i = tid; i < 17 * 64; i += 512) { const int j = i >> 6, l = i & 63; float s = 0.f;
                    for (int w = 0; w < 8; ++w) s += red[(w * 17 + j) * 64 + l];
                    const int nn = (it % 96) * 64 + l; MODV[((size_t)layer * 17 + j) * 6144 + nn] = s + INP(5)[layer * 6144 + nn]; }
                __syncthreads();
            }
        }
        }
        { PH_LOCALS
        for (long i = gt; i < 2048 * 64; i += NGT) { const int t = (int)(i >> 6), pi = (int)(i & 63);
            const int j = pi & 31; const float inv = 1.0f / powf(10000.0f, (float)(2 * j) / 64.0f);
            const float pos = pi < 32 ? (float)(t >> 6) : (float)(t & 63); const float ang = pos * inv;
            ROPEC[i] = cosf(ang); ROPES[i] = sinf(ang); }
        }
        { PH_LOCALS
        for (long i = gt; i < 2 * 2 * 32 * 64; i += NGT) {
            const int p = (int)(i & 63), g = (int)((i >> 6) & 31), ld = (int)(i >> 11);
            const float lre = INP(9)[i], lim = INP(10)[i]; const float dt = expf(INP(11)[ld * 32 + g]);
            f32x2* o = LP + i * 18;
            for (int k = 0; k <= 16; ++k) { const float m = expf(lre * dt * (float)k), an = lim * dt * (float)k; o[k] = (f32x2){m * cosf(an), m * sinf(an)}; }
            const float m1 = expf(lre * dt), a1 = lim * dt; const float nr = m1 * cosf(a1) - 1.0f, ni = m1 * sinf(a1); const float den = lre * lre + lim * lim;
            o[17] = (f32x2){(nr * lre + ni * lim) / den, (ni * lre - nr * lim) / den};
            (void)p;
        }
        }
    }
    ++ph; if (ph > a.ph_lo && ph < a.ph_hi) grid.sync();
    XcdBarrier xbar; xbar.bar = (unsigned*)a.ws; xbar.x = 0; xbar.st = (volatile LAS unsigned*)(lds + 131072);
    if (a.ph_hi - a.ph_lo > 1) xbar = xcd_barrier_post((unsigned*)a.ws, (volatile LAS unsigned*)(lds + 131072));
    RUNP(1) {
        { PH_LOCALS
        for (long i = gt; i < 2 * 2 * 32 * 4096; i += NGT) {
            const int hp = (int)(i & 15), h = (int)((i >> 4) & 15), k = (int)((i >> 8) & 15); const int ldg = (int)(i >> 12);
            const float* cre = INP(14) + (size_t)ldg * 1024 + h * 64; const float* cim = INP(15) + (size_t)ldg * 1024 + h * 64;
            const float* bre = INP(12) + (size_t)ldg * 1024 + hp; const float* bim = INP(13) + (size_t)ldg * 1024 + hp;
            const f32x2* lp = LP + (size_t)ldg * 64 * 18; float s = 0.f;
            for (int p = 0; p < 64; ++p) { const f32x2 L = lp[p * 18 + k], bb = lp[p * 18 + 17];
                const float br = bre[p * 16], bi = bim[p * 16]; const float xr = bb.x * br - bb.y * bi, xi = bb.x * bi + bb.y * br;
                const float yr = L.x * xr - L.y * xi, yi = L.x * xi + L.y * xr;
                s += cre[p] * yr - cim[p] * yi; }
            KT[i] = s;
        }
        }
        { PH_LOCALS
        for (long i = gt; i < 2L * 32 * 256 * 32; i += NGT) {
            const int k8 = (int)(i & 31), n = (int)((i >> 5) & 255), g = (int)((i >> 13) & 31), l = (int)(i >> 18);
            const int d = n >> 7, p = (n >> 1) & 63, cpt = n & 1, tau = k8 >> 1, h0 = (k8 & 1) * 8;
            const size_t ldg = ((size_t)l * 2 + d) * 32 + g; const f32x2* lp = LP + (ldg * 64 + p) * 18;
            const f32x2 L = lp[d == 0 ? 15 - tau : tau], bb = lp[17]; const float zr = L.x * bb.x - L.y * bb.y, zi = L.x * bb.y + L.y * bb.x;
            const float* bre = INP(12) + ldg * 1024 + p * 16 + h0; const float* bim = INP(13) + ldg * 1024 + p * 16 + h0; float o[8];
#pragma unroll
            for (int j = 0; j < 8; ++j) o[j] = cpt == 0 ? zr * bre[j] - zi * bim[j] : zr * bim[j] + zi * bre[j];
            *(u32x4*)(EBm + (((size_t)l * 32 + g) * 256 + n) * 256 + k8 * 8) = pack8(o);
        }
        }
        { PH_LOCALS
        for (long i = gt; i < 2L * 32 * 256 * 32; i += NGT) {
            const int k8 = (int)(i & 31), n = (int)((i >> 5) & 255), g = (int)((i >> 13) & 31), l = (int)(i >> 18);
            const int d = k8 >> 4, p0 = (k8 & 15) * 4, tau = n >> 4, h = n & 15;
            const size_t ldg = ((size_t)l * 2 + d) * 32 + g; float o[8];
#pragma unroll
            for (int q = 0; q < 4; ++q) { const int p = p0 + q; const f32x2 L = LP[(ldg * 64 + p) * 18 + (d == 0 ? tau + 1 : 16 - tau)];
                const float cr = INP(14)[ldg * 1024 + h * 64 + p], ci = INP(15)[ldg * 1024 + h * 64 + p];
                o[2 * q] = cr * L.x - ci * L.y; o[2 * q + 1] = -(cr * L.y + ci * L.x); }
            *(u32x4*)(TRm + (((size_t)l * 32 + g) * 256 + n) * 512 + 256 + k8 * 8) = pack8(o);
        }
        }
    }
    SEAM();

    if (RUN()) {
        convert_weights<0>(a, lds, G0, bx0, wave0);
        { PH_LOCALS
        const float* mod0 = MODV;
        for (int mb = gw; mb < FMH; mb += 4 * NGW) {
            f32x4 v[4][4]; int mm[4]; bool ok[4];
#pragma unroll
            for (int j = 0; j < 4; ++j) { const int m = mb + j * NGW; ok[j] = m < FMH; mm[j] = ok[j] ? m : mb;
                ld_row(v[j], mm[j] < FML ? x_in + (size_t)mm[j] * D : ctx_in + (size_t)(mm[j] - FML) * D, lane); }
#pragma unroll
            for (int j = 0; j < 4; ++j) { const float* mv = mod0 + (size_t)(mm[j] < FML ? (mm[j] >> 11) : 16) * 6144;
                ln_mod_regs(v[j], mv, mv + 1024, HbF + (size_t)hrow_of(mm[j]) * D, lane, ok[j]); }
        } }
    }
    SEAM();
    layer_half<0, 0>(a, lds, lds_raw, ph, xbar, G0, bx0, wave0);
    layer_half<0, 1>(a, lds, lds_raw, ph, xbar, G0, bx0, wave0);
    ffn_full<0>(a, lds, lds_raw, ph, xbar, G0, bx0, wave0);
    layer_half<1, 0>(a, lds, lds_raw, ph, xbar, G0, bx0, wave0);
    layer_half<1, 1>(a, lds, lds_raw, ph, xbar, G0, bx0, wave0);
    ffn_full<1>(a, lds, lds_raw, ph, xbar, G0, bx0, wave0);
}
constexpr int N_PHASES = 3 + DEPTH * (3 + 4 + 4);

extern "C" void kernel_launch(void* const* d_in, const int* in_sizes, int n_in, void* d_out, int out_size, void* d_ws, size_t ws_size, hipStream_t stream) {
    static int grid = 0;
    if (grid == 0) {
        if (n_in != 30 || out_size != NBATCH * SEQ * D || ws_size < WS_FEND || ws_size < WS_O2 + 36 * MiB) { fprintf(stderr, "kernel_launch: unexpected shapes (n_in %d out %d ws %zu)\n", n_in, out_size, ws_size); grid = -1; return; }
        int dev = 0, cus = 0, per_cu = 0;
        hipGetDevice(&dev); hipDeviceGetAttribute(&cus, hipDeviceAttributeMultiprocessorCount, dev);
        if (hipFuncSetAttribute((const void*)mega_fwd, hipFuncAttributeMaxDynamicSharedMemorySize, LDS_BYTES) != hipSuccess) { fprintf(stderr, "kernel_launch: hipFuncSetAttribute failed\n"); grid = -1; return; }
        if (hipOccupancyMaxActiveBlocksPerMultiprocessor(&per_cu, (const void*)mega_fwd, 512, LDS_BYTES) != hipSuccess || per_cu < 1) { fprintf(stderr, "kernel_launch: occupancy query gave %d\n", per_cu); per_cu = 1; (void)hipGetLastError(); }
        grid = cus * per_cu;
    }
    if (grid < 0) return;
    Args a{};
    for (int i = 0; i < 30; ++i) a.in[i] = (const float*)d_in[i];
    a.out = (float*)d_out; a.ws = (unsigned char*)d_ws;
#if MK_MULTI
    for (int p = 0; p < N_PHASES; ++p) { a.ph_lo = p; a.ph_hi = p + 1; hipLaunchKernelGGL(mega_fwd, dim3(grid), dim3(512), LDS_BYTES, stream, a); }
#else
    a.ph_lo = 0; a.ph_hi = N_PHASES;
    void* args[] = {&a};
    hipError_t e = hipLaunchCooperativeKernel((void*)mega_fwd, dim3(grid), dim3(512), args, LDS_BYTES, stream);
    if (e != hipSuccess) fprintf(stderr, "kernel_launch: cooperative launch failed: %s (grid %d)\n", hipGetErrorString(e), grid);
#endif
}
```

```cpp
#include <hip/hip_runtime.h>
#include <hip/hip_cooperative_groups.h>
#include <cstdio>
#include <cstdint>
namespace cg = cooperative_groups;

#ifndef PROBE_MASK
#define PROBE_MASK 0
#endif
#ifndef MK_MULTI
#define MK_MULTI 0
#endif

#define LAS __attribute__((address_space(3)))
typedef unsigned short bf16_t;
typedef short bf16x8 __attribute__((ext_vector_type(8)));
typedef short s16x4 __attribute__((ext_vector_type(4)));
typedef float f32x4 __attribute__((ext_vector_type(4)));
typedef float f32x2 __attribute__((ext_vector_type(2)));
typedef float f32x16 __attribute__((ext_vector_type(16)));
typedef unsigned u32x4 __attribute__((ext_vector_type(4)));
typedef unsigned u32x2 __attribute__((ext_vector_type(2)));

constexpr int D = 1024, NBATCH = 16, SEQ = 2048, CTX = 256, DEPTH = 2;
constexpr int HBT = 8;
constexpr int ML = HBT * SEQ, MC = HBT * CTX, MH = ML + MC;
constexpr int INC = 6656, DFF = 2816, SEQA = SEQ + CTX;
constexpr int NCH = SEQA / 16, A2R = 2048;
constexpr int FML = NBATCH * SEQ, FMC = NBATCH * CTX, FMH = FML + FMC;
constexpr float LN_EPS = 1e-6f, RMS_EPS = 1e-6f;
constexpr float DN_ALPHA = 1.4142135623730951f;

constexpr size_t MiB = 1u << 20;
constexpr size_t WS_MODV = 1 * MiB;
constexpr size_t WS_ROPE = 2 * MiB;
constexpr size_t WS_LP = 3 * MiB;
constexpr size_t WS_KT = 5 * MiB;
constexpr size_t WS_STATS = 7 * MiB;
constexpr size_t WS_EB = 8 * MiB;
constexpr size_t WS_TR = 16 * MiB;
constexpr size_t WS_CTXRES = 32 * MiB;
constexpr size_t WS_WB = 48 * MiB;
constexpr size_t WS_H = 86 * MiB;
constexpr size_t WS_BIG = 158 * MiB;
constexpr size_t WS_KB = WS_BIG, WS_VB = WS_KB + 9 * MiB, WS_QO = WS_VB + 9 * MiB, WS_AX = WS_QO + 36 * MiB, WS_BG = WS_AX + 18 * MiB,
                 WS_CG = WS_BG + 18 * MiB, WS_GT = WS_CG + 18 * MiB, WS_A2 = WS_GT + 108 * MiB, WS_MIX_END = WS_A2 + 64 * MiB;
constexpr size_t WS_E2 = WS_MIX_END;
constexpr size_t WS_O2 = WS_E2 + 36 * MiB;
constexpr size_t WS_MG = WS_E2;

constexpr size_t WS_FACT = WS_H + 72 * MiB  , WS_FSB = WS_FACT + 198 * MiB, WS_FEND = WS_FSB + 10 * MiB;
static_assert(WS_FEND <= 512 * MiB, "ws map");
constexpr size_t WS_UV = WS_BIG, WS_ACT = WS_UV + 198 * MiB, WS_SB = WS_ACT + 99 * MiB, WS_END = WS_SB + 5 * MiB;
static_assert(WS_O2 + 36 * MiB <= 512 * MiB && WS_END <= 512 * MiB, "ws map");
constexpr size_t WO_IN = 0, WO_CO = WO_IN + (size_t)INC * D, WO_GLU = WO_CO + (size_t)D * 512, WO_AO = WO_GLU + (size_t)2048 * 512,
                 WO_O = WO_AO + (size_t)D * D, WO_UP = WO_O + (size_t)D * D, WO_DN = WO_UP + (size_t)2 * DFF * D, WO_END = WO_DN + (size_t)D * DFF;
static_assert(WO_END * 2 <= 38 * MiB, "weights");

constexpr int LDS_BYTES = 131072 + 1024 + 8192;

__device__ __forceinline__ unsigned opq(unsigned v) { asm volatile("" : "+s"(v)); return v; }
#define WSP(off) (ws + ((size_t)opq((unsigned)((off) >> 20)) << 20))
__device__ __forceinline__ unsigned cvt_pk_bf16(float lo, float hi) { unsigned r; asm volatile("v_cvt_pk_bf16_f32 %0, %1, %2" : "=v"(r) : "v"(lo), "v"(hi)); return r; }
__device__ __forceinline__ float bflo(unsigned w) { return __uint_as_float(w << 16); }
__device__ __forceinline__ float bfhi(unsigned w) { return __uint_as_float(w & 0xffff0000u); }
__device__ __forceinline__ float sigm(float x) { return __builtin_amdgcn_rcpf(1.0f + __builtin_amdgcn_exp2f(-1.4426950408889634f * x)); }
__device__ __forceinline__ float gelu_t(float x) { const float e = __builtin_amdgcn_exp2f(x * fmaf(x * x, -0.10294324f, -2.3022082f)); return x * __builtin_amdgcn_rcpf(1.0f + e); }
__device__ __forceinline__ float wave_sum(float v) {
#pragma unroll
    for (int o = 1; o < 64; o <<= 1) v += __shfl_xor(v, o);
    return v;
}
__device__ __forceinline__ void unpack8(u32x4 w, float* f) { f[0] = bflo(w.x); f[1] = bfhi(w.x); f[2] = bflo(w.y); f[3] = bfhi(w.y); f[4] = bflo(w.z); f[5] = bfhi(w.z); f[6] = bflo(w.w); f[7] = bfhi(w.w); }
__device__ __forceinline__ u32x4 pack8(const float* f) { u32x4 w; w.x = cvt_pk_bf16(f[0], f[1]); w.y = cvt_pk_bf16(f[2], f[3]); w.z = cvt_pk_bf16(f[4], f[5]); w.w = cvt_pk_bf16(f[6], f[7]); return w; }

namespace pg8 {
constexpr int BM = 256, BK = 64, HALF = 128, HTB = HALF * BK * 2, STAGE_BYTES = 8 * HTB, NXCD = 8, WGM = 8;
__host__ __device__ __forceinline__ int lds_byte(int r, int c) { const int st = (r >> 4) * 2 + (c >> 5), rr = r & 15, cc = c & 31, ob = rr * 64 + cc * 2; return st * 1024 + (ob ^ (((ob >> 9) & 1) << 5)); }
__host__ __device__ __forceinline__ void stage_rc(int b, int& R, int& C) { const int st = b / 1024, sb = b % 1024, swz = sb ^ (((sb >> 9) & 1) << 5); R = (st >> 1) * 16 + swz / 64; C = (st & 1) * 32 + (swz % 64) / 2; }
__host__ __device__ __forceinline__ int perm32(int rho) { const int n = rho >> 4, i = rho & 15; return 8 * (i >> 2) + 4 * n + (i & 3); }

struct Unit { int pm, pn; };
struct Gemm { const bf16_t* A; const bf16_t* Bt; };

struct Order {
    int nM, nN, nwg, G, c, xM0, xNN, xcnt, sub;
    __device__ __forceinline__ void init(int nM_, int nN_, int G_, int c_) { nM = nM_; nN = nN_; nwg = nM * nN; G = G_; c = c_; xM0 = 0; xNN = 1; xcnt = 0; sub = 1; }
    __device__ __forceinline__ bool next(int i, Unit& u) const {
        const int ib = i / sub, is = i - ib * sub;
        long L = (long)ib * G + c;
        if (L < nwg) {
            int wgid = (int)L; { const int q = nwg / NXCD, r = nwg % NXCD, xcd = wgid % NXCD, off = wgid / NXCD; wgid = (xcd < r ? xcd * (q + 1) : r * (q + 1) + (xcd - r) * q) + off; }
            const int nig = WGM * nN, gid = wgid / nig, fm = gid * WGM, gsz = (nM - fm) < WGM ? (nM - fm) : WGM;
            u.pm = fm + ((wgid % nig) % gsz); u.pn = ((wgid % nig) / gsz) * sub + is; return true;
        }
        L -= nwg; if (L >= xcnt) return false;
        u.pm = xM0 + (int)L / xNN; u.pn = ((int)L % xNN) * sub + is; return true;
    }
};
struct OneUnit {
    int pm, pn;
    __device__ __forceinline__ bool next(int i, Unit& u) const { if (i != 0) return false; u.pm = pm; u.pn = pn; return true; }
};

template <int LDA, int LDB, int KK, class Epi, class Sched>
__device__ __forceinline__ void gemm_phase(LAS unsigned char* lds, const Gemm g, const Sched& S, const Epi& E, const int tid) {
    const int wid = __builtin_amdgcn_readfirstlane(tid >> 6), lane = tid & 63, wr = wid >> 2, wc = wid & 3, fr = lane & 15, fq = lane >> 4;
    constexpr int nt = KK / BK;
    unsigned voffA[2], voffB[2];
#pragma unroll
    for (int i = 0; i < 2; ++i) { int R, C; stage_rc(tid * 16 + i * 8192, R, C); const int Rb = Epi::PERM ? ((R & ~31) + perm32(R & 31)) : R;
        voffA[i] = (unsigned)(R * LDA + C) * 2u; voffB[i] = (unsigned)(Rb * LDB + C) * 2u; }
    constexpr size_t kstep = (size_t)(BK * 2);
    constexpr size_t hstepA = (size_t)HALF * LDA * 2, hstepB = (size_t)HALF * LDB * 2;
    constexpr size_t tstepA = 2 * hstepA, tstepB = 2 * hstepB;
    const unsigned ldsw = (unsigned)wid * 1024u;
    const int aoff = lds_byte(wr * 64 + fr, fq * 8), boff = lds_byte(wc * 32 + fr, fq * 8);
#define PG8_SA(b, h) (((b) * 2 + (h)) * HTB)
#define PG8_SB(b, h) ((4 + (b) * 2 + (h)) * HTB)
#define PG8_STAGE(bufoff, gbase, voff) do { _Pragma("unroll") for (int _i = 0; _i < 2; ++_i) \
        __builtin_amdgcn_global_load_lds((const unsigned*)((const char*)(gbase) + (voff)[_i]), (LAS unsigned*)(lds + (bufoff) + ldsw + _i * 8192), 16, 0, 0); } while (0)
#define PG8_LDA(dst, b, h) do { _Pragma("unroll") for (int m = 0; m < 4; ++m) _Pragma("unroll") for (int k = 0; k < 2; ++k) dst[m][k] = *(const LAS bf16x8*)(lds + PG8_SA(b, h) + aoff + m * 2048 + k * 1024); } while (0)
#define PG8_LDB(dst, b, h) do { _Pragma("unroll") for (int n = 0; n < 2; ++n) _Pragma("unroll") for (int k = 0; k < 2; ++k) dst[n][k] = *(const LAS bf16x8*)(lds + PG8_SB(b, h) + boff + n * 2048 + k * 1024); } while (0)
#define PG8_MMA(ai, bj, At, Bt) do { __builtin_amdgcn_s_setprio(1); _Pragma("unroll") for (int m = 0; m < 4; ++m) _Pragma("unroll") for (int n = 0; n < 2; ++n) _Pragma("unroll") for (int k = 0; k < 2; ++k) \
        acc[ai][bj][m][n] = __builtin_amdgcn_mfma_f32_16x16x32_bf16(Bt[n][k], At[m][k], acc[ai][bj][m][n], 0, 0, 0); __builtin_amdgcn_s_setprio(0); } while (0)
#define PG8_WAIT_V(n) asm volatile("s_waitcnt vmcnt(" #n ")" ::: "memory")
#define PG8_WAIT_L(n) asm volatile("s_waitcnt lgkmcnt(" #n ")" ::: "memory")
#define PG8_BAR __builtin_amdgcn_s_barrier()
#define PG8_SCHED __builtin_amdgcn_sched_barrier(0)
    Unit cur, nxt; int ui = 0;
    if (!S.next(0, cur)) return;
    f32x4 acc[2][2][4][2];
#pragma unroll
    for (int a = 0; a < 2; ++a)
#pragma unroll
        for (int b = 0; b < 2; ++b)
#pragma unroll
            for (int m = 0; m < 4; ++m)
#pragma unroll
                for (int n = 0; n < 2; ++n) acc[a][b][m][n] = (f32x4){0.f, 0.f, 0.f, 0.f};
    bf16x8 At[4][2], B0[2][2], B1[2][2];
    const char* cA = (const char*)g.A + (size_t)cur.pm * tstepA; const char* cB = (const char*)g.Bt + (size_t)cur.pn * tstepB;
    PG8_STAGE(PG8_SB(0, 0), cB, voffB); PG8_STAGE(PG8_SB(0, 1), cB + hstepB, voffB); PG8_STAGE(PG8_SA(0, 0), cA, voffA); PG8_STAGE(PG8_SA(0, 1), cA + hstepA, voffA);
    if (wr == 1) PG8_BAR;
    PG8_WAIT_V(2); PG8_BAR;
    PG8_STAGE(PG8_SB(1, 0), cB + kstep, voffB); PG8_STAGE(PG8_SA(1, 0), cA + kstep, voffA); PG8_STAGE(PG8_SB(1, 1), cB + hstepB + kstep, voffB);
    PG8_WAIT_V(6); PG8_BAR;
    for (;;) {
        const bool has_next = S.next(ui + 1, nxt);
        const char* nA = has_next ? (const char*)g.A + (size_t)nxt.pm * tstepA : cA; const char* nB = has_next ? (const char*)g.Bt + (size_t)nxt.pn * tstepB : cB;
#pragma unroll 1
        for (int t = 0; t < nt; t += 2) {
            const bool last = (t == nt - 2);
            const char* a1 = cA + (size_t)(t + 1) * kstep;
            const char* a2 = last ? nA : cA + (size_t)(t + 2) * kstep; const char* b2 = last ? nB : cB + (size_t)(t + 2) * kstep;
            const char* a3 = a2 + kstep; const char* b3 = b2 + kstep;
            PG8_LDB(B0, 0, 0); PG8_LDB(B1, 0, 1); PG8_SCHED; PG8_LDA(At, 0, 0); PG8_STAGE(PG8_SA(1, 1), a1 + hstepA, voffA);
            PG8_WAIT_V(8); PG8_WAIT_L(0); PG8_BAR; PG8_MMA(0, 0, At, B0); PG8_MMA(0, 1, At, B1); PG8_BAR; PG8_SCHED;
            PG8_LDA(At, 0, 1); PG8_STAGE(PG8_SB(0, 0), b2, voffB); PG8_STAGE(PG8_SB(0, 1), b2 + hstepB, voffB); PG8_STAGE(PG8_SA(0, 0), a2, voffA);
            PG8_WAIT_V(8); PG8_WAIT_L(0); PG8_BAR; PG8_MMA(1, 0, At, B0); PG8_MMA(1, 1, At, B1); PG8_BAR; PG8_SCHED;
            PG8_LDB(B0, 1, 0); PG8_LDB(B1, 1, 1); PG8_SCHED; PG8_LDA(At, 1, 0); PG8_STAGE(PG8_SA(0, 1), a2 + hstepA, voffA);
            PG8_WAIT_V(8); PG8_WAIT_L(0); PG8_BAR; PG8_MMA(0, 0, At, B0); PG8_MMA(0, 1, At, B1); PG8_BAR; PG8_SCHED;
            PG8_LDA(At, 1, 1); PG8_STAGE(PG8_SB(1, 0), b3, voffB); PG8_STAGE(PG8_SB(1, 1), b3 + hstepB, voffB); PG8_STAGE(PG8_SA(1, 0), a3, voffA);
            PG8_WAIT_V(8); PG8_WAIT_L(0); PG8_BAR; PG8_MMA(1, 0, At, B0); PG8_MMA(1, 1, At, B1); PG8_BAR; PG8_SCHED;
        }
        if (wr == 0) PG8_BAR;
        E(acc, cur, wr, wc, fr, fq);
        if (!has_next) break;
#pragma unroll
        for (int a = 0; a < 2; ++a)
#pragma unroll
            for (int b = 0; b < 2; ++b)
#pragma unroll
                for (int m = 0; m < 4; ++m)
#pragma unroll
                    for (int n = 0; n < 2; ++n) acc[a][b][m][n] = (f32x4){0.f, 0.f, 0.f, 0.f};
        cur = nxt; cA = nA; cB = nB; ++ui;
        if (wr == 1) PG8_BAR;
    }
    PG8_WAIT_V(0);
    PG8_BAR;
#undef PG8_SA
#undef PG8_SB
#undef PG8_STAGE
#undef PG8_LDA
#undef PG8_LDB
#undef PG8_MMA
#undef PG8_WAIT_V
#undef PG8_WAIT_L
#undef PG8_BAR
#undef PG8_SCHED
}

typedef const f32x4 (&AccRef)[2][2][4][2];
__device__ __forceinline__ u32x4 pack_acc(f32x4 v0, f32x4 v1) { u32x4 w; w.x = cvt_pk_bf16(v0[0], v0[1]); w.y = cvt_pk_bf16(v0[2], v0[3]); w.z = cvt_pk_bf16(v1[0], v1[1]); w.w = cvt_pk_bf16(v1[2], v1[3]); return w; }

struct EpiIn {
    static constexpr bool PERM = true;
    unsigned char* ws; const float* qg; const float* kg; LAS float* xs;
    __device__ __forceinline__ void operator()(AccRef acc, const Unit& u, int wr, int wc, int fr, int fq) const {
        bf16_t* const KB = (bf16_t*)WSP(WS_KB); bf16_t* const VB = (bf16_t*)WSP(WS_VB); bf16_t* const QO = (bf16_t*)WSP(WS_QO); bf16_t* const AX = (bf16_t*)WSP(WS_AX);
        bf16_t* const BG = (bf16_t*)WSP(WS_BG); bf16_t* const CG = (bf16_t*)WSP(WS_CG); bf16_t* const GT = (bf16_t*)WSP(WS_GT); bf16_t* const A2 = (bf16_t*)WSP(WS_A2);
        const int pn = u.pn, colw = wc * 32 + 8 * fq;
        if (pn == 0 || (pn >= 4 && pn < 8)) {
            const float* gv = (pn == 0 ? kg : qg) + colw; const f32x4 g0 = *(const f32x4*)gv, g1 = *(const f32x4*)(gv + 4);
            const float* ropec = (const float*)(ws + WS_ROPE); const float* ropes = ropec + 2048 * 64;
#pragma unroll
            for (int ai = 0; ai < 2; ++ai)
#pragma unroll
                for (int m = 0; m < 4; ++m)
#pragma unroll
                    for (int bj = 0; bj < 2; ++bj) { const f32x4 a0 = acc[ai][bj][m][0], a1 = acc[ai][bj][m][1];
                        float s2 = (a0[0] * a0[0] + a0[1] * a0[1]) + (a0[2] * a0[2] + a0[3] * a0[3]) + (a1[0] * a1[0] + a1[1] * a1[1]) + (a1[2] * a1[2] + a1[3] * a1[3]);
                        s2 += __shfl_xor(s2, 16); s2 += __shfl_xor(s2, 32);
                        if (fq == 0) xs[((ai * HALF + wr * 64 + m * 16 + fr) * 2 + bj) * 4 + wc] = s2; }
            asm volatile("s_waitcnt lgkmcnt(0)" ::: "memory"); __builtin_amdgcn_s_barrier(); asm volatile("" ::: "memory");
#pragma unroll
            for (int ai = 0; ai < 2; ++ai)
#pragma unroll
                for (int m = 0; m < 4; ++m) {
                    const int rt = ai * HALF + wr * 64 + m * 16 + fr, r = u.pm * BM + rt;
                    int bl, sp; if (r < ML) { bl = r >> 11; sp = 256 + (r & 2047); } else { const int rc = r - ML; bl = rc >> 8; sp = rc & 255; }
                    const bool rope = r < ML; f32x4 cs = {1.f, 1.f, 1.f, 1.f}, sn = {0.f, 0.f, 0.f, 0.f};
                    if (rope) { const int pi = (r & 2047) * 64 + 16 * wc + 4 * fq; cs = *(const f32x4*)(ropec + pi); sn = *(const f32x4*)(ropes + pi); }
#pragma unroll
                    for (int bj = 0; bj < 2; ++bj) {
                        const f32x4 ps = *(const LAS f32x4*)(xs + (rt * 2 + bj) * 4); const float rn = rsqrtf(((ps[0] + ps[1]) + (ps[2] + ps[3])) * (1.f / 128.f) + RMS_EPS);
                        f32x4 v0 = acc[ai][bj][m][0] * rn * g0, v1 = acc[ai][bj][m][1] * rn * g1;
                        const f32x4 w0 = {v0[0] * cs[0] - v0[1] * sn[0], v0[0] * sn[0] + v0[1] * cs[0], v0[2] * cs[1] - v0[3] * sn[1], v0[2] * sn[1] + v0[3] * cs[1]};
                        const f32x4 w1 = {v1[0] * cs[2] - v1[1] * sn[2], v1[0] * sn[2] + v1[1] * cs[2], v1[2] * cs[3] - v1[3] * sn[3], v1[2] * sn[3] + v1[3] * cs[3]};
                        const int c = bj * HALF + colw;
                        bf16_t* dst = pn == 0 ? (bf16_t*)(ws + WS_KB) + (size_t)(bl * SEQA + sp) * 256 + c : (bf16_t*)(ws + WS_QO) + (size_t)r * 1024 + (pn - 4) * 256 + c;
                        *(u32x4*)dst = pack_acc(w0, w1); }
                }
            return;
        }
#pragma unroll
        for (int ai = 0; ai < 2; ++ai)
#pragma unroll
            for (int m = 0; m < 4; ++m) {
                const int r = u.pm * BM + ai * HALF + wr * 64 + m * 16 + fr;
                int bl, sp; if (r < ML) { bl = r >> 11; sp = 256 + (r & 2047); } else { const int rc = r - ML; bl = rc >> 8; sp = rc & 255; }
#pragma unroll
                for (int bj = 0; bj < 2; ++bj) {
                    const int c = bj * HALF + colw; f32x4 v0 = acc[ai][bj][m][0], v1 = acc[ai][bj][m][1]; bf16_t* dst;
                    if (pn == 0) dst = KB + (size_t)(bl * SEQA + sp) * 256 + c;
                    else if (pn == 1) dst = VB + (size_t)(bl * SEQA + sp) * 256 + c;
                    else if (pn < 4) { const int cu = (pn - 2) * 256 + c, gg = cu >> 4, h0 = cu & 15; dst = A2 + ((size_t)(gg * A2R + bl * 256 + (sp >> 4)) * 512 + (sp & 15) * 16 + h0); }
                    else if (pn < 8) dst = QO + (size_t)r * 1024 + (pn - 4) * 256 + c;
                    else if (pn < 10) dst = AX + (size_t)r * 512 + (pn - 8) * 256 + c;
                    else if (pn < 12) dst = BG + (size_t)r * 512 + (pn - 10) * 256 + c;
                    else if (pn < 14) dst = CG + (size_t)r * 512 + (pn - 12) * 256 + c;
                    else { dst = GT + (size_t)r * 3072 + (pn - 14) * 256 + c;
#pragma unroll
                        for (int j = 0; j < 4; ++j) { v0[j] = sigm(v0[j]); v1[j] = sigm(v1[j]); } }
                    *(u32x4*)dst = pack_acc(v0, v1);
                }
            }
    }
};
struct EpiSsm1 {
    static constexpr bool PERM = true;
    bf16_t* A2;
    __device__ __forceinline__ void operator()(AccRef acc, const Unit& u, int wr, int wc, int fr, int fq) const {
        const int colw = wc * 32 + 8 * fq;
#pragma unroll
        for (int ai = 0; ai < 2; ++ai)
#pragma unroll
            for (int m = 0; m < 4; ++m) { const int r = u.pm * BM + ai * HALF + wr * 64 + m * 16 + fr;
#pragma unroll
                for (int bj = 0; bj < 2; ++bj) *(u32x4*)(A2 + (size_t)r * 256 + bj * HALF + colw) = pack_acc(acc[ai][bj][m][0], acc[ai][bj][m][1]); }
    }
};
struct EpiSsm2 {
    static constexpr bool PERM = true;
    bf16_t* Y;
    __device__ __forceinline__ void operator()(AccRef acc, const Unit& u, int wr, int wc, int fr, int fq) const {
        const int colw = wc * 32 + 8 * fq, gg = u.pn, bl = u.pm & 7;
#pragma unroll
        for (int ai = 0; ai < 2; ++ai)
#pragma unroll
            for (int m = 0; m < 4; ++m) { const int rl = ai * HALF + wr * 64 + m * 16 + fr;
                if (rl < NCH) { const int ch = rl;
#pragma unroll
                    for (int bj = 0; bj < 2; ++bj) { const int c = bj * HALF + colw, tau = c >> 4, h0 = c & 15, sp = ch * 16 + tau;
                        const int mrow = sp < 256 ? ML + bl * 256 + sp : bl * 2048 + sp - 256;
                        f32x4 v0 = acc[ai][bj][m][0], v1 = acc[ai][bj][m][1];
#pragma unroll
                        for (int j = 0; j < 4; ++j) { v0[j] = gelu_t(v0[j]); v1[j] = gelu_t(v1[j]); }
                        *(u32x4*)(Y + (size_t)mrow * 512 + gg * 16 + h0) = pack_acc(v0, v1); } } }
    }
};
template <int MODE  > struct EpiMerge {
    static constexpr bool PERM = true;
    unsigned char* ws;
    __device__ __forceinline__ void operator()(AccRef acc, const Unit& u, int wr, int wc, int fr, int fq) const {
        bf16_t* const MG = (bf16_t*)WSP(WS_MG); const bf16_t* const GT = (const bf16_t*)WSP(WS_GT);
        const int colw = wc * 32 + 8 * fq;
#pragma unroll
        for (int ai = 0; ai < 2; ++ai) {
            const int r0 = u.pm * BM + ai * HALF + wr * 64 + fr;
            if (MODE == 1) {
                const int c = u.pn * 128 + colw; u32x4 gtv[4], mgv[4];
#pragma unroll
                for (int m = 0; m < 4; ++m) { const int r = r0 + m * 16; gtv[m] = *(const u32x4*)(GT + (size_t)r * 3072 + 1024 + c); mgv[m] = *(const u32x4*)(MG + (size_t)r * 1024 + c); }
                asm volatile("s_waitcnt vmcnt(0)" ::: "memory");
#pragma unroll
                for (int m = 0; m < 4; ++m) { const int r = r0 + m * 16; float gt[8], mg[8], o[8]; unpack8(gtv[m], gt); unpack8(mgv[m], mg);
                    const f32x4 a0 = acc[ai][0][m][0], a1 = acc[ai][0][m][1], g0 = acc[ai][1][m][0], g1 = acc[ai][1][m][1];
#pragma unroll
                    for (int j = 0; j < 4; ++j) { o[j] = mg[j] + gt[j] * a0[j] * sigm(g0[j]); o[4 + j] = mg[4 + j] + gt[4 + j] * a1[j] * sigm(g1[j]); }
                    *(u32x4*)(MG + (size_t)r * 1024 + c) = pack8(o); }
            } else {
                u32x4 gtv[4][2], mgv[4][2];
#pragma unroll
                for (int m = 0; m < 4; ++m)
#pragma unroll
                    for (int bj = 0; bj < 2; ++bj) { const int r = r0 + m * 16, c = u.pn * 256 + bj * HALF + colw;
                        gtv[m][bj] = *(const u32x4*)(GT + (size_t)r * 3072 + (MODE == 0 ? 0 : 2048) + c);
                        if (MODE == 2) mgv[m][bj] = *(const u32x4*)(MG + (size_t)r * 1024 + c); }
                asm volatile("s_waitcnt vmcnt(0)" ::: "memory");
#pragma unroll
                for (int m = 0; m < 4; ++m)
#pragma unroll
                    for (int bj = 0; bj < 2; ++bj) { const int r = r0 + m * 16, c = u.pn * 256 + bj * HALF + colw; float gt[8], mg[8], o[8];
                        unpack8(gtv[m][bj], gt); if (MODE == 2) unpack8(mgv[m][bj], mg);
                        const f32x4 a0 = acc[ai][bj][m][0], a1 = acc[ai][bj][m][1];
#pragma unroll
                        for (int j = 0; j < 4; ++j) { o[j] = (MODE == 2 ? mg[j] : 0.f) + gt[j] * a0[j]; o[4 + j] = (MODE == 2 ? mg[4 + j] : 0.f) + gt[4 + j] * a1[j]; }
                        *(u32x4*)(MG + (size_t)r * 1024 + c) = pack8(o); }
            }
        }
    }
};
template <bool LN> struct EpiRes {
    static constexpr bool PERM = false;
    const float *resL, *resC; float *outL, *outC; const float* gate;
    int hb, mlr;
    const float *stats, *lg, *lb; int sL, sC;
    __device__ __forceinline__ void operator()(AccRef acc, const Unit& u, int wr, int wc, int fr, int fq) const {
        const bool lat = u.pm < mlr / BM;
        const float* res = lat ? resL : resC; float* out = lat ? outL : outC;
        const int col0 = u.pn * BM + wc * 32 + 4 * fq;
        const int bidx = lat ? hb + ((u.pm * BM) >> 11) : 16;
        const float* gp = gate + (size_t)bidx * 6144 + col0; f32x4 gv[2][2], lgv[2][2], lbv[2][2];
#pragma unroll
        for (int bj = 0; bj < 2; ++bj)
#pragma unroll
            for (int n = 0; n < 2; ++n) { gv[bj][n] = *(const f32x4*)(gp + bj * HALF + n * 16);
                if (LN) { lgv[bj][n] = *(const f32x4*)(lg + col0 + bj * HALF + n * 16); lbv[bj][n] = *(const f32x4*)(lb + col0 + bj * HALF + n * 16); } }
#pragma unroll
        for (int ai = 0; ai < 2; ++ai)
#pragma unroll
            for (int mh = 0; mh < 2; ++mh) {
                const int r0 = u.pm * BM + ai * HALF + wr * 64 + mh * 32 + fr; f32x4 rv[2][2][2]; f32x2 st[2];
#pragma unroll
                for (int m = 0; m < 2; ++m) { const int r = r0 + m * 16; const int rr = lat ? r : r - mlr; const size_t off = (size_t)rr * 1024 + col0;
                    if (LN) st[m] = *(const f32x2*)(stats + 2 * (size_t)(lat ? sL + r : sC + rr));
#pragma unroll
                    for (int bj = 0; bj < 2; ++bj)
#pragma unroll
                        for (int n = 0; n < 2; ++n) rv[m][bj][n] = *(const f32x4*)(res + off + bj * HALF + n * 16); }
                asm volatile("s_waitcnt vmcnt(0)" ::: "memory");
#pragma unroll
                for (int m = 0; m < 2; ++m) { const int r = r0 + m * 16; const size_t off = (size_t)(lat ? r : r - mlr) * 1024 + col0;
#pragma unroll
                    for (int bj = 0; bj < 2; ++bj)
#pragma unroll
                        for (int n = 0; n < 2; ++n) { f32x4 x = rv[m][bj][n];
                            if (LN) x = (x - st[m].x) * st[m].y * lgv[bj][n] + lbv[bj][n];
                            *(f32x4*)(out + off + bj * HALF + n * 16) = x * DN_ALPHA + gv[bj][n] * acc[ai][bj][mh * 2 + m][n]; } }
            }
    }
};
__device__ __forceinline__ float dpp_ror1(float x) { return __int_as_float(__builtin_amdgcn_mov_dpp(__float_as_int(x), 0x121, 0xf, 0xf, false)); }
__device__ __forceinline__ float dpp_rol1(float x) { return __int_as_float(__builtin_amdgcn_mov_dpp(__float_as_int(x), 0x12F, 0xf, 0xf, false)); }
struct EpiUp {
    static constexpr bool PERM = true;
    bf16_t* ACTp; float* SB; const float* fw; const float* fb; LAS float* xl;
    __device__ __forceinline__ void operator()(AccRef acc, const Unit& u, int wr, int wc, int fr, int fq) const {
        const int blk_col = wc * 32 + 8 * fq;
#pragma unroll
        for (int ai = 0; ai < 2; ++ai) { const int blk = ai * 2 + wr;
            if (fr == 0) {
#pragma unroll
                for (int n = 0; n < 2; ++n)
#pragma unroll
                    for (int j = 0; j < 4; ++j) xl[blk * 128 + blk_col + 4 * n + j] = acc[ai][0][0][n][j]; }
            if (fr == 15) {
#pragma unroll
                for (int n = 0; n < 2; ++n)
#pragma unroll
                    for (int j = 0; j < 4; ++j) xl[512 + blk * 128 + blk_col + 4 * n + j] = acc[ai][0][3][n][j]; } }
        asm volatile("s_waitcnt lgkmcnt(0)" ::: "memory"); __builtin_amdgcn_s_barrier(); asm volatile("" ::: "memory");
        const int acol0 = u.pn * 128 + blk_col;
        float w0[8], w1[8], w2[8], bb[8];
#pragma unroll
        for (int q = 0; q < 8; ++q) { w0[q] = fw[acol0 + q]; w1[q] = fw[DFF + acol0 + q]; w2[q] = fw[2 * DFF + acol0 + q]; bb[q] = fb[acol0 + q]; }
#pragma unroll
        for (int ai = 0; ai < 2; ++ai) { const int blk = ai * 2 + wr;
#pragma unroll
            for (int m = 0; m < 4; ++m) {
                const int rt = ai * HALF + wr * 64 + m * 16 + fr;
                float o[8];
#pragma unroll
                for (int n = 0; n < 2; ++n)
#pragma unroll
                    for (int j = 0; j < 4; ++j) { const int q = 4 * n + j; const float uc = acc[ai][0][m][n][j];
                        float pv, nx;
                        if (m > 0) pv = dpp_ror1(fr == 15 ? acc[ai][0][m > 0 ? m - 1 : 0][n][j] : uc);
                        else { pv = dpp_ror1(uc); const float t = (blk > 0 && fr == 0) ? xl[512 + (blk - 1) * 128 + blk_col + q] : 0.f; pv = fr == 0 ? t : pv; }
                        if (m < 3) nx = dpp_rol1(fr == 0 ? acc[ai][0][m < 3 ? m + 1 : 3][n][j] : uc);
                        else { nx = dpp_rol1(uc); const float t = (blk < 3 && fr == 15) ? xl[(blk + 1) * 128 + blk_col + q] : 0.f; nx = fr == 15 ? t : nx; }
                        o[q] = gelu_t(w0[q] * pv + w1[q] * uc + w2[q] * nx + bb[q]) * acc[ai][1][m][n][j]; }
                const bool edge = (ai == 0 && m == 0) ? (wr == 0 && fr <= 1) : ((ai == 1 && m == 3) ? (wr == 1 && fr >= 14) : false);
                if ((ai == 0 && m == 0) || (ai == 1 && m == 3)) {
                    if (rt != 0 && rt != 255) *(u32x4*)(ACTp + (size_t)(u.pm * BM + rt) * DFF + acol0) = pack8(o);
                    if (edge) { const int slot = rt <= 1 ? rt : rt - 252; float* sb = SB + ((size_t)u.pm * 6 + slot) * DFF + acol0;
                        *(f32x4*)sb = acc[ai][0][m][0]; *(f32x4*)(sb + 4) = acc[ai][0][m][1];
                        if (rt == 0 || rt == 255) { float* sv = SB + ((size_t)u.pm * 6 + (rt == 0 ? 4 : 5)) * DFF + acol0; *(f32x4*)sv = acc[ai][1][m][0]; *(f32x4*)(sv + 4) = acc[ai][1][m][1]; } }
                } else *(u32x4*)(ACTp + (size_t)(u.pm * BM + rt) * DFF + acol0) = pack8(o);
            } }
    }
};
struct EpiStore {
    static constexpr bool PERM = true;
    bf16_t* O; int ldc;
    __device__ __forceinline__ void operator()(AccRef acc, const Unit& u, int wr, int wc, int fr, int fq) const {
        const int colw = u.pn * BM + wc * 32 + 8 * fq;
#pragma unroll
        for (int ai = 0; ai < 2; ++ai)
#pragma unroll
            for (int m = 0; m < 4; ++m) { const int r = u.pm * BM + ai * HALF + wr * 64 + m * 16 + fr;
#pragma unroll
                for (int bj = 0; bj < 2; ++bj) *(u32x4*)(O + (size_t)r * ldc + bj * HALF + colw) = pack_acc(acc[ai][bj][m][0], acc[ai][bj][m][1]); }
    }
};
}

namespace att {
constexpr int AD = 128, NW = 8, QBLK = 32, KVBLK = 64;
constexpr float SCALE = 0.088388347648318440f;
constexpr float THR = 8.f;
constexpr int LDQ = 1024, LDK = 256, LDO = 1024;
constexpr size_t SHM_V = KVBLK * AD * 2, SHM_K = KVBLK * AD * 2, SHM_ATTN = 2 * SHM_V + 2 * SHM_K + NW * 64 * 4;
#define KSWZ(row, colB) ((row) * 256 + ((colB) ^ (((row) & 7) << 4)))
#define SBAR() __builtin_amdgcn_sched_barrier(0)
__device__ __forceinline__ int crow(int r, int hi) { return (r & 3) + 8 * (r >> 2) + 4 * hi; }
__device__ __forceinline__ void partialSM(f32x16& p0, f32x16& p1, float& m_reg, float& mn, float& alpha) {
  constexpr float C = SCALE * 1.4426950408889634f;
  float pmax = p0[0]; for (int r = 1; r < 16; ++r) pmax = fmaxf(pmax, p0[r]); for (int r = 0; r < 16; ++r) pmax = fmaxf(pmax, p1[r]);
  { auto rr = __builtin_amdgcn_permlane32_swap(__float_as_uint(pmax), __float_as_uint(pmax), false, false);
    pmax = fmaxf(__uint_as_float(rr[0]), __uint_as_float(rr[1])); }
  if (__builtin_expect(__all(pmax - m_reg <= THR / SCALE), 1)) { mn = m_reg; alpha = 1.f; }
  else { mn = fmaxf(m_reg, pmax); alpha = __builtin_amdgcn_exp2f((m_reg - mn) * C); m_reg = mn; }
  float mnC = -mn * C;
  for (int r = 0; r < 16; ++r) p0[r] = fmaf(p0[r], C, mnC); for (int r = 0; r < 16; ++r) p1[r] = fmaf(p1[r], C, mnC);
  for (int r = 0; r < 16; ++r) p0[r] = __builtin_amdgcn_exp2f(p0[r]);
}
__device__ __forceinline__ void finishSM(f32x16& p0, f32x16& p1, float alpha, float& l_reg, bf16x8& pa0, bf16x8& pa1, bf16x8& pa2, bf16x8& pa3) {
  for (int r = 0; r < 16; ++r) p1[r] = __builtin_amdgcn_exp2f(p1[r]);
  float ps = 0; for (int r = 0; r < 16; ++r) ps += p0[r]; for (int r = 0; r < 16; ++r) ps += p1[r];
  { auto rr = __builtin_amdgcn_permlane32_swap(__float_as_uint(ps), __float_as_uint(ps), false, false);
    ps = __uint_as_float(rr[0]) + __uint_as_float(rr[1]); }
  l_reg = l_reg * alpha + ps;
#define PK4(P, BASE, OUT) do { unsigned a0 = cvt_pk_bf16(P[BASE + 0], P[BASE + 1]), a1 = cvt_pk_bf16(P[BASE + 2], P[BASE + 3]);   \
    unsigned b0 = cvt_pk_bf16(P[BASE + 4], P[BASE + 5]), b1 = cvt_pk_bf16(P[BASE + 6], P[BASE + 7]);                              \
    auto r0 = __builtin_amdgcn_permlane32_swap(a0, b0, false, false); auto r1 = __builtin_amdgcn_permlane32_swap(a1, b1, false, false); \
    u32x4 w = {r0[0], r1[0], r0[1], r1[1]}; OUT = *reinterpret_cast<bf16x8*>(&w); } while (0)
  PK4(p0, 0, pa0); PK4(p0, 8, pa1); PK4(p1, 0, pa2); PK4(p1, 8, pa3);
#undef PK4
}
__device__ __forceinline__ void qkt(f32x16& p0, f32x16& p1, const bf16_t* Ks, const bf16x8* qr, int r32, int hi) {
  p0 = f32x16{}; p1 = f32x16{};
  for (int d0 = 0; d0 < 8; ++d0) { int cb = (d0 * 16 + hi * 8) * 2;
    bf16x8 b0 = *reinterpret_cast<const bf16x8*>((const char*)Ks + KSWZ(r32, cb));
    bf16x8 b1 = *reinterpret_cast<const bf16x8*>((const char*)Ks + KSWZ(32 + r32, cb));
    p0 = __builtin_amdgcn_mfma_f32_32x32x16_bf16(b0, qr[d0], p0, 0, 0, 0);
    p1 = __builtin_amdgcn_mfma_f32_32x32x16_bf16(b1, qr[d0], p1, 0, 0, 0); }
}
__device__ __forceinline__ int v_st(int k, int c) { const int kk = (k & ~0xC) | ((k & 4) << 1) | ((k & 8) >> 1); return ((kk >> 3) * 4 + (c >> 5)) * 512 + ((kk & 7) * 32 + (c & 31)) * 2; }
__device__ __forceinline__ int v_rd_base(int lane) { return ((lane & 3) << 3) | (((lane >> 2) & 3) << 6) | (((lane >> 4) & 1) << 5) | (((lane >> 5) & 1) << 8); }
constexpr int v_rd_off(int d0, int ks, int half) { return d0 * 512 + ks * 4096 + half * 2048; }
template <int OFF> __device__ __forceinline__ s16x4 tr_read(int vb) {
  s16x4 r; asm volatile("ds_read_b64_tr_b16 %0, %1 offset:%2" : "=&v"(r) : "v"(vb), "i"(OFF) : "memory"); return r;
}
template <int D0> __device__ __forceinline__ void pv_one(f32x16& od, int vb, bf16x8 pa0, bf16x8 pa1, bf16x8 pa2, bf16x8 pa3) {
  const s16x4 l0 = tr_read<v_rd_off(D0, 0, 0)>(vb), h0 = tr_read<v_rd_off(D0, 0, 1)>(vb), l1 = tr_read<v_rd_off(D0, 1, 0)>(vb), h1 = tr_read<v_rd_off(D0, 1, 1)>(vb);
  const s16x4 l2 = tr_read<v_rd_off(D0, 2, 0)>(vb), h2 = tr_read<v_rd_off(D0, 2, 1)>(vb), l3 = tr_read<v_rd_off(D0, 3, 0)>(vb), h3 = tr_read<v_rd_off(D0, 3, 1)>(vb);
  asm volatile("s_waitcnt lgkmcnt(0)" ::: "memory"); SBAR();
#define PK(L, H) (bf16x8){L[0], L[1], L[2], L[3], H[0], H[1], H[2], H[3]}
  od = __builtin_amdgcn_mfma_f32_32x32x16_bf16(pa0, PK(l0, h0), od, 0, 0, 0);
  od = __builtin_amdgcn_mfma_f32_32x32x16_bf16(pa1, PK(l1, h1), od, 0, 0, 0);
  od = __builtin_amdgcn_mfma_f32_32x32x16_bf16(pa2, PK(l2, h2), od, 0, 0, 0);
  od = __builtin_amdgcn_mfma_f32_32x32x16_bf16(pa3, PK(l3, h3), od, 0, 0, 0);
#undef PK
}
__device__ __forceinline__ void pv_d0(f32x16* o, int vb, bf16x8 pa0, bf16x8 pa1, bf16x8 pa2, bf16x8 pa3) {
  pv_one<0>(o[0], vb, pa0, pa1, pa2, pa3); pv_one<1>(o[1], vb, pa0, pa1, pa2, pa3); pv_one<2>(o[2], vb, pa0, pa1, pa2, pa3); pv_one<3>(o[3], vb, pa0, pa1, pa2, pa3);
}
__device__ __forceinline__ void attn_dense_body(const bf16_t* __restrict__ Qb, const bf16_t* __restrict__ Kh, const bf16_t* __restrict__ Vh,
                                                bf16_t* __restrict__ Ob, int seq, char* lds, const int tid, const int wid) {
  const int  lane = tid & 63, r32 = lane & 31, hi = lane >> 5;
  bf16_t* V_lds = (bf16_t*)lds; bf16_t* K_lds = (bf16_t*)(lds + 2 * SHM_V);
  float* ws = (float*)(lds + 2 * SHM_V + 2 * SHM_K) + wid * 64; float* li_l = ws; float* al_l = ws + 32;
  float m_reg = -1e30f, l_reg = 0; f32x16 o[4] = {}; bf16x8 qr[8];
  const bf16_t* Qw = Qb + (long)(wid * QBLK) * LDQ + (unsigned)(r32 * LDQ + hi * 8);
#pragma unroll
  for (int d0 = 0; d0 < 8; ++d0) qr[d0] = *reinterpret_cast<const bf16x8*>(Qw + d0 * 16);
  const int sr = tid >> 4, sc = (tid & 15) * 8, vst0 = v_st(sr, sc), vst1 = v_st(32 + sr, sc);
  const int vb0 = (int)(uintptr_t)V_lds + v_rd_base(lane);
  const unsigned so0 = (unsigned)(sr * LDK + sc), so1 = (unsigned)((32 + sr) * LDK + sc);
  struct { bf16x8 vs0, vs1, ks0, ks1; } sr_[2];
#define LD8(p) (*reinterpret_cast<const bf16x8*>(p))
#define SLOAD(i, k0) do { const bf16_t* Vt_ = Vh + (long)(k0) * LDK; const bf16_t* Kt_ = Kh + (long)(k0) * LDK; \
    sr_[i].vs0 = LD8(Vt_ + so0); sr_[i].vs1 = LD8(Vt_ + so1); sr_[i].ks0 = LD8(Kt_ + so0); sr_[i].ks1 = LD8(Kt_ + so1); } while (0)
#define SWRITE(b, i) do { *(bf16x8*)((char*)V_lds + (b) * SHM_V + vst0) = sr_[i].vs0;          \
    *(bf16x8*)((char*)V_lds + (b) * SHM_V + vst1) = sr_[i].vs1; int kc = sc * 2;               \
    *(bf16x8*)((char*)K_lds + (b) * SHM_K + KSWZ(sr, kc)) = sr_[i].ks0;                       \
    *(bf16x8*)((char*)K_lds + (b) * SHM_K + KSWZ(32 + sr, kc)) = sr_[i].ks1; } while (0)
#define SWAIT() asm volatile("s_waitcnt vmcnt(4)" ::: "memory")
#define RESC(a) do { if (__any((a) < 1.f)) { if (hi == 0) al_l[r32] = (a); asm volatile("s_waitcnt lgkmcnt(0)" ::: "memory"); \
    for (int d = 0; d < 4; ++d) for (int r = 0; r < 16; ++r) o[d][r] *= al_l[crow(r, hi)]; } } while (0)
  f32x16 pA0, pA1, pB0, pB1; float mnA, mnB, alA, alB; bf16x8 pa0, pa1, pa2, pa3; const int NT = seq / KVBLK;
  constexpr int SE = 0, SO = 1;
  SLOAD(SE, 0); asm volatile("s_waitcnt vmcnt(0)" ::: "memory"); SWRITE(0, SE); __syncthreads();
  qkt(pA0, pA1, K_lds, qr, r32, hi); partialSM(pA0, pA1, m_reg, mnA, alA);
  SLOAD(SO, KVBLK); if (2 < NT) SLOAD(SE, 2 * KVBLK);
  SWAIT(); SWRITE(1, SO); __syncthreads();
  for (int j = 1; j + 1 < NT; j += 2) {
    SBAR(); qkt(pB0, pB1, (bf16_t*)((char*)K_lds + SHM_K), qr, r32, hi);
    finishSM(pA0, pA1, alA, l_reg, pa0, pa1, pa2, pa3); SBAR();
    SLOAD(SO, (j + 2) * KVBLK); SBAR();
    pv_d0(o, vb0, pa0, pa1, pa2, pa3); partialSM(pB0, pB1, m_reg, mnB, alB);
    __syncthreads(); SWAIT(); SWRITE(0, SE);
    RESC(alB); __syncthreads();
    SBAR(); qkt(pA0, pA1, K_lds, qr, r32, hi);
    finishSM(pB0, pB1, alB, l_reg, pa0, pa1, pa2, pa3); SBAR();
    if (j + 3 < NT) SLOAD(SE, (j + 3) * KVBLK); SBAR();
    pv_d0(o, vb0 + (int)SHM_V, pa0, pa1, pa2, pa3); partialSM(pA0, pA1, m_reg, mnA, alA);
    __syncthreads(); SWAIT(); SWRITE(1, SO);
    RESC(alA); __syncthreads();
  }
  SBAR(); qkt(pB0, pB1, (bf16_t*)((char*)K_lds + SHM_K), qr, r32, hi);
  finishSM(pA0, pA1, alA, l_reg, pa0, pa1, pa2, pa3); SBAR();
  pv_d0(o, vb0, pa0, pa1, pa2, pa3); partialSM(pB0, pB1, m_reg, mnB, alB);
  __syncthreads(); RESC(alB);
  finishSM(pB0, pB1, alB, l_reg, pa0, pa1, pa2, pa3); SBAR();
  pv_d0(o, vb0 + (int)SHM_V, pa0, pa1, pa2, pa3);
  if (hi == 0) li_l[r32] = l_reg; asm volatile("s_waitcnt lgkmcnt(0)" ::: "memory");
  float rli[16];
#pragma unroll
  for (int r = 0; r < 16; ++r) rli[r] = __builtin_amdgcn_rcpf(li_l[crow(r, hi)]);
  bf16_t* Ow = Ob + (long)(wid * QBLK) * LDO;
  int lane_e = lane; asm volatile("" : "+v"(lane_e)); const int r32e = lane_e & 31, hie = lane_e >> 5;
#pragma unroll
  for (int r = 0; r < 16; ++r) { const unsigned orow = (unsigned)crow(r, hie);
    for (int d0 = 0; d0 < 4; ++d0) Ow[orow * (unsigned)LDO + (unsigned)(d0 * 32 + r32e)] = (bf16_t)(cvt_pk_bf16(o[d0][r] * rli[r], 0.f) & 0xffffu); }
  __syncthreads();
#undef LD8
#undef SLOAD
#undef SWRITE
#undef SWAIT
#undef RESC
}
}

struct Args { const float* in[30]; float* out; unsigned char* ws; int ph_lo, ph_hi; };

__device__ __forceinline__ void transpose_item(const float* W, int K, int N, bf16_t* WT, int k0, int n0, int dst_row0, LAS float* scr, int lane) {
    float wv[32];
#pragma unroll
    for (int i = 0; i < 32; ++i) { const int kk = 2 * i + (lane >> 5); wv[i] = W[(size_t)(k0 + kk) * N + n0 + (lane & 31)]; }
#pragma unroll
    for (int i = 0; i < 32; ++i) { const int kk = 2 * i + (lane >> 5); scr[kk * 33 + (lane & 31)] = wv[i]; }
    asm volatile("s_waitcnt lgkmcnt(0)" ::: "memory");
    const int c = lane & 7;
#pragma unroll
    for (int j = 0; j < 4; ++j) { const int n = (lane >> 3) + 8 * j; const LAS float* s = scr + (8 * c) * 33 + n;
        u32x4 o; o.x = cvt_pk_bf16(s[0 * 33], s[1 * 33]); o.y = cvt_pk_bf16(s[2 * 33], s[3 * 33]); o.z = cvt_pk_bf16(s[4 * 33], s[5 * 33]); o.w = cvt_pk_bf16(s[6 * 33], s[7 * 33]);
        *(u32x4*)(WT + (size_t)(dst_row0 + n) * K + k0 + 8 * c) = o; }
    asm volatile("s_waitcnt lgkmcnt(0)" ::: "memory");
}
__device__ __forceinline__ int up_row(int n0) { return n0 < DFF ? (n0 >> 7) * 256 + (n0 & 127) : ((n0 - DFF) >> 7) * 256 + 128 + ((n0 - DFF) & 127); }
__device__ __forceinline__ int glu_row(int n0) { return n0 < 1024 ? (n0 >> 7) * 256 + (n0 & 127) : ((n0 - 1024) >> 7) * 256 + 128 + ((n0 - 1024) & 127); }

__device__ __forceinline__ void ld_row(f32x4 (&v)[4], const float* src, int lane) {
#pragma unroll
    for (int q = 0; q < 4; ++q) v[q] = *(const f32x4*)(src + lane * 4 + 256 * q);
}
__device__ __forceinline__ void ln_stats(f32x4 (&v)[4], float& rstd, float& mean_out) {
    float s = 0.f;
#pragma unroll
    for (int q = 0; q < 4; ++q) s += (v[q][0] + v[q][1]) + (v[q][2] + v[q][3]);
    const float mean = wave_sum(s) * (1.f / D); mean_out = mean; float s2 = 0.f;
#pragma unroll
    for (int q = 0; q < 4; ++q) { v[q] = v[q] - mean; s2 += (v[q][0] * v[q][0] + v[q][1] * v[q][1]) + (v[q][2] * v[q][2] + v[q][3] * v[q][3]); }
    rstd = rsqrtf(wave_sum(s2) * (1.f / D) + LN_EPS);
}
__device__ __forceinline__ void ln_mod_regs(f32x4 (&v)[4], const float* shift, const float* scale, bf16_t* dst, int lane, bool ok) {
    float rstd, mean_; ln_stats(v, rstd, mean_);
    if (ok) {
#pragma unroll
        for (int q = 0; q < 4; ++q) { const int c = lane * 4 + 256 * q; const f32x4 sc = *(const f32x4*)(scale + c), sh = *(const f32x4*)(shift + c);
            const f32x4 y = v[q] * rstd * (sc + 1.0f) + sh; u32x2 w; w.x = cvt_pk_bf16(y[0], y[1]); w.y = cvt_pk_bf16(y[2], y[3]); *(u32x2*)(dst + c) = w; }
    }
}
__device__ __forceinline__ void post_norm_regs(f32x4 (&v)[4], float* rx, const float* lg, const float* lb, bool do_mod, const float* shift, const float* scale, bf16_t* dst, int lane, bool ok, bool write_x, float* st2) {
    float rstd, mean_; ln_stats(v, rstd, mean_);
    if (!write_x && ok && lane == 0) *(f32x2*)st2 = (f32x2){mean_, rstd};
#pragma unroll
    for (int q = 0; q < 4; ++q) { const int c = lane * 4 + 256 * q; v[q] = v[q] * rstd * *(const f32x4*)(lg + c) + *(const f32x4*)(lb + c); if (ok && write_x) *(f32x4*)(rx + c) = v[q]; }
    if (do_mod) ln_mod_regs(v, shift, scale, dst, lane, ok);
}

#define XB_TMO      128
#define XB_XCNT(j)  (256  + 64 * (j))
#define XB_XSUB(j)  (1280 + 64 * (j))
#define XB_XGEN(j)  (2304 + 64 * (j))
#define XB_TOP      3328
#define XB_TOPGEN   3392
#define XCD_BAR_WORDS 3456
#define XB_SPIN_CAP (1u << 18)

__device__ __forceinline__ unsigned xb_ld(unsigned* p)              { return __hip_atomic_load(p, __ATOMIC_RELAXED, __HIP_MEMORY_SCOPE_AGENT); }
__device__ __forceinline__ unsigned xb_add(unsigned* p, unsigned v) { return __hip_atomic_fetch_add(p, v, __ATOMIC_RELAXED, __HIP_MEMORY_SCOPE_AGENT); }
__device__ __forceinline__ unsigned xb_xcc_id() { return (unsigned)__builtin_amdgcn_s_getreg((3 << 11) | 20) & 0xFu; }
#define XB_SPIN(cond, bar) do { unsigned _sp = 0; while (cond) { __builtin_amdgcn_s_sleep(1); \
    if ((++_sp & 255u) == 0u) { if (xb_ld(&(bar)[XB_TMO])) break; if (_sp > XB_SPIN_CAP) { atomicAdd(&(bar)[XB_TMO], 1u); break; } } } } while (0)

struct XcdBarrier {
    unsigned* bar; unsigned x;
    volatile LAS unsigned* st;
};

__device__ __forceinline__ XcdBarrier xcd_barrier_post(unsigned* bar, volatile LAS unsigned* st) {
    XcdBarrier b; b.bar = bar; b.x = xb_xcc_id(); b.st = st;
    if (threadIdx.x == 0) (void)xb_add(&bar[XB_XCNT(b.x)], 1u);
    return b;
}
__device__ __forceinline__ void xcd_barrier_complete(unsigned* bar, unsigned x, unsigned& nloc, unsigned& nx) {
    const unsigned G = gridDim.x * gridDim.y * gridDim.z;
    unsigned sum, cnt, mine, sp = 0u;
    for (;;) {
        sum = 0u; cnt = 0u; mine = 0u;
#pragma unroll
        for (unsigned j = 0; j < 16; ++j) { const unsigned c = xb_ld(&bar[XB_XCNT(j)]); sum += c; cnt += (c > 0u) ? 1u : 0u; mine = (j == x) ? c : mine; }
        if (sum == G) break;
        __builtin_amdgcn_s_sleep(1);
        if ((++sp & 255u) == 0u) { if (xb_ld(&bar[XB_TMO])) break; if (sp > XB_SPIN_CAP) { atomicAdd(&bar[XB_TMO], 1u); break; } }
    }
    nloc = mine > 0u ? mine : 1u; nx = cnt > 0u ? cnt : 1u;
}

__device__ __forceinline__ void xcd_barrier(const XcdBarrier& b) {
    asm volatile("s_waitcnt vmcnt(0)" ::: "memory");
    __syncthreads();
    if (threadIdx.x == 0) {
        unsigned* bar = b.bar;
        __builtin_amdgcn_s_waitcnt(0);
        unsigned nloc = b.st[0], nx = b.st[1];
        if (nloc == 0u) { xcd_barrier_complete(bar, b.x, nloc, nx); b.st[0] = nloc; b.st[1] = nx; }
        const unsigned old = xb_add(&bar[XB_XSUB(b.x)], 1u);
        const unsigned gen = old / nloc;
        if (old + 1u == (gen + 1u) * nloc) {
            __builtin_amdgcn_fence(__ATOMIC_RELEASE, "agent");
            asm volatile("s_waitcnt vmcnt(0)" ::: "memory");
            const unsigned og = xb_add(&bar[XB_TOP], 1u);
            const unsigned tg = og / nx;
            if (og + 1u == (tg + 1u) * nx) xb_add(&bar[XB_TOPGEN], 1u);
            else XB_SPIN(xb_ld(&bar[XB_TOPGEN]) == tg, bar);
            __builtin_amdgcn_fence(__ATOMIC_ACQUIRE, "agent");
            xb_add(&bar[XB_XGEN(b.x)], 1u);
            asm volatile("s_waitcnt vmcnt(0)" ::: "memory");
        } else {
            XB_SPIN(xb_ld(&bar[XB_XGEN(b.x)]) == gen, bar);
            __builtin_amdgcn_fence(__ATOMIC_ACQUIRE, "agent");
            asm volatile("s_waitcnt vmcnt(0)" ::: "memory");
        }
    }
    __syncthreads();
}


    typedef const __attribute__((address_space(4))) unsigned char* kptr_t;
#define PH_LOCALS \
    unsigned lz_ = 0u; asm volatile("" : "+v"(lz_)); const int lane = (int)__builtin_amdgcn_mbcnt_hi(~0u, __builtin_amdgcn_mbcnt_lo(~0u, lz_)); \
    int G = G0; asm volatile("" : "+s"(G)); int bx = bx0; asm volatile("" : "+s"(bx)); int wave = wave0; asm volatile("" : "+s"(wave)); \
    const int NGW = G * 8; const long NGT = (long)G * 512; (void)NGW; (void)NGT; const int tid = wave * 64 + lane; \
    const int gw = bx * 8 + wave; const long gt = (long)bx * 512 + tid; (void)gw; (void)gt; (void)lane; \
    __attribute__((address_space(1))) unsigned char* ws_ = (__attribute__((address_space(1))) unsigned char*)a.ws; asm volatile("" : "+s"(ws_)); unsigned char* const ws = (unsigned char*)ws_; \
    kptr_t kp = (kptr_t)__builtin_amdgcn_kernarg_segment_ptr(); asm volatile("" : "+s"(kp)); (void)kp;
#define INP(k) ((const float*)(*(const __attribute__((address_space(1))) float* const __attribute__((address_space(4)))*)(kp + 8 * (k))))
#define MODV ((float*)WSP(WS_MODV))
#define STATS ((float*)WSP(WS_STATS))
#define ROPEC ((float*)WSP(WS_ROPE))
#define ROPES (ROPEC + 2048 * 64)
#define LP ((f32x2*)WSP(WS_LP))
#define KT ((float*)WSP(WS_KT))
#define EBm ((bf16_t*)WSP(WS_EB))
#define TRm ((bf16_t*)WSP(WS_TR))
#define CTXRES ((float*)WSP(WS_CTXRES))
#define WB ((bf16_t*)WSP(WS_WB))
#define Hb ((bf16_t*)WSP(WS_H + (size_t)hf * 36 * MiB))
#define HbF ((bf16_t*)WSP(WS_H))
#define KB ((bf16_t*)WSP(WS_KB))
#define VB ((bf16_t*)WSP(WS_VB))
#define QO ((bf16_t*)WSP(WS_QO))
#define AX ((bf16_t*)WSP(WS_AX))
#define BGb ((bf16_t*)WSP(WS_BG))
#define CGb ((bf16_t*)WSP(WS_CG))
#define GT ((bf16_t*)WSP(WS_GT))
#define A2 ((bf16_t*)WSP(WS_A2))
#define E2 ((bf16_t*)WSP(WS_E2))
#define MG ((bf16_t*)WSP(WS_MG))
#define O2 ((bf16_t*)WSP(WS_O2))
#define CV ((bf16_t*)WSP(WS_H + (size_t)hf * 36 * MiB))
#define Yb ((bf16_t*)WSP(WS_H + (size_t)hf * 36 * MiB + 18 * MiB))
#define UV ((bf16_t*)WSP(WS_UV))
#define ACT ((bf16_t*)WSP(WS_ACT))
#define SBF ((float*)WSP(WS_FSB))
#define ACTF ((bf16_t*)WSP(WS_FACT))
#define x_in INP(0)
#define c_in INP(1)
#define ctx_in INP(2)
#define cctx_in INP(3)
#define modL (MODV + (size_t)layer * 17 * 6144)
#define EBl (EBm + (size_t)layer * 32 * 256 * 256)
#define TRl (TRm + (size_t)layer * 32 * 256 * 512)
#define resL0 ((layer == 0 ? x_in : (const float*)a.out) + (size_t)hf * ML * D)
#define resC0 ((layer == 0 ? ctx_in : (const float*)CTXRES) + (size_t)hf * MC * D)
#define outL (a.out + (size_t)hf * ML * D)
#define outC (CTXRES + (size_t)hf * MC * D)

#define RUN() (ph >= a.ph_lo && ph < a.ph_hi)
#define RUNP(id) for (int rep_ = 0; rep_ < (((PROBE_MASK >> (id)) & 1) ? 2 : 1); ++rep_, __syncthreads()) if (RUN())
#define SEAM() do { ++ph; if (ph > a.ph_lo && ph < a.ph_hi) xcd_barrier(xbar); } while (0)
template <int layer>
__device__ __forceinline__ void convert_weights(const Args& a, LAS unsigned char* lds, const int G0, const int bx0, const int wave0) {
    { PH_LOCALS
                    LAS float* scr = (LAS float*)(lds + wave * 16384);
                    constexpr int I_IN = 16 * (INC / 32), I_CO = 8 * 32, I_GLU = 8 * 64, I_AO = 16 * 32, I_O = 16 * 32, I_UP = 16 * (2 * DFF / 32), I_DN = (DFF / 64) * 32;
                    constexpr int NIT = I_IN + I_CO + I_GLU + I_AO + I_O + I_UP + I_DN;
                    for (int it = gw; it < NIT; it += NGW) {
                        int r = it; const float* W; int K, N; bf16_t* WT; bool glu = false, upw = false;
                        if (r < I_IN) { W = INP(6) + (size_t)layer * D * INC; K = D; N = INC; WT = (bf16_t*)(WSP(WS_WB + WO_IN * 2)); }
                        else if ((r -= I_IN) < I_CO) { W = INP(8) + (size_t)layer * 512 * D; K = 512; N = D; WT = (bf16_t*)(WSP(WS_WB + WO_CO * 2)); }
                        else if ((r -= I_CO) < I_GLU) { W = INP(17) + (size_t)layer * 512 * 2048; K = 512; N = 2048; WT = (bf16_t*)(WSP(WS_WB + WO_GLU * 2)); glu = true; }
                        else if ((r -= I_GLU) < I_AO) { W = INP(20) + (size_t)layer * D * D; K = D; N = D; WT = (bf16_t*)(WSP(WS_WB + WO_AO * 2)); }
                        else if ((r -= I_AO) < I_O) { W = INP(21) + (size_t)layer * D * D; K = D; N = D; WT = (bf16_t*)(WSP(WS_WB + WO_O * 2)); }
                        else if ((r -= I_O) < I_UP) { W = INP(24) + (size_t)layer * D * 2 * DFF; K = D; N = 2 * DFF; WT = (bf16_t*)(WSP(WS_WB + WO_UP * 2)); upw = true; }
                        else { r -= I_UP; W = INP(27) + (size_t)layer * DFF * D; K = DFF; N = D; WT = (bf16_t*)(WSP(WS_WB + WO_DN * 2)); }
                        const int nblk = N / 32, kb = r / nblk, nb = r % nblk, n0 = 32 * nb;
                        transpose_item(W, K, N, WT, 64 * kb, n0, glu ? glu_row(n0) : (upw ? up_row(n0) : n0), scr, lane);
                    }
                    } { PH_LOCALS
                    for (long i = gt; i < 32L * 256 * 32; i += NGT) {
                        const int k8 = (int)(i & 31), n = (int)((i >> 5) & 255), g = (int)(i >> 13);
                        const int tau = n >> 4, h = n & 15, tp = k8 >> 1, h0 = (k8 & 1) * 8; float o[8];
                        const float* kf = KT + ((((size_t)layer * 2 + 0) * 32 + g) * 16) * 256; const float* kr = KT + ((((size_t)layer * 2 + 1) * 32 + g) * 16) * 256;
#pragma unroll
                        for (int j = 0; j < 8; ++j) { const int hp = h0 + j; float v = 0.f;
                            if (tp <= tau) v += kf[(tau - tp) * 256 + h * 16 + hp];
                            if (tp >= tau) v += kr[(tp - tau) * 256 + h * 16 + hp];
                            if (tp == tau && hp == h) v += INP(16)[layer * 512 + g * 16 + h];
                            o[j] = v; }
                        *(u32x4*)(TRm + (((size_t)layer * 32 + g) * 256 + n) * 512 + k8 * 8) = pack8(o);
                    } }
}
__device__ __forceinline__ int hrow_of(int m) {
    if (m < NBATCH * SEQ) { const int b = m >> 11, t = m & 2047; return (b >> 3) * MH + (b & 7) * SEQ + t; }
    const int mc = m - NBATCH * SEQ, b = mc >> 8, t = mc & 255; return (b >> 3) * MH + ML + (b & 7) * CTX + t;
}
template <int layer, int hf>
__device__ __forceinline__ void g_phase(const Args& a, LAS unsigned char* lds, const int G0, const int bx0, const int wave0) {
    constexpr bool last = (layer == DEPTH - 1);
    { PH_LOCALS
        pg8::Gemm g{MG, (bf16_t*)(WSP(WS_WB + WO_O * 2))}; pg8::Order S; S.init((last ? ML : MH) / 256, 4, G, hf == 0 ? G - 1 - bx : bx);
        pg8::EpiRes<(layer > 0)> E{resL0, resC0, outL, outC, modL + 2048, hf * HBT, ML, STATS, INP(28) + (layer > 0 ? layer - 1 : 0) * D, INP(29) + (layer > 0 ? layer - 1 : 0) * D, hf * ML, FML + hf * MC};
        pg8::gemm_phase<D, D, D>(lds, g, S, E, tid);
    }
}
template <int layer, int hf>
__device__ __forceinline__ void layer_half(const Args& a, LAS unsigned char* lds, unsigned char* lds_raw, int& ph, const XcdBarrier& xbar, const int G0, const int bx0, const int wave0) {
    constexpr bool last = (layer == DEPTH - 1);
            RUNP(3) {
                if (hf == 1) g_phase<layer, 0>(a, lds, G0, bx0, wave0);
                PH_LOCALS
                pg8::Gemm g{Hb, (bf16_t*)(WSP(WS_WB + WO_IN * 2))}; pg8::Order S;
                if (!last) S.init(MH / 256, INC / 256, G, bx); else { S.init(ML / 256, INC / 256, G, bx); S.xM0 = ML / 256; S.xNN = 4; S.xcnt = (MC / 256) * 4; }
                pg8::EpiIn E{ws, INP(18) + layer * 128, INP(19) + layer * 128, (LAS float*)(lds + 131072 + 1024)};
                pg8::gemm_phase<D, D, D>(lds, g, S, E, tid);
            }
            SEAM();
            RUNP(4) {
                for (int L = bx0; L < 256; L += G0) {
                    const int g = L >> 3, bl = L & 7;
                    { PH_LOCALS pg8::Gemm g1{A2, EBl}; pg8::OneUnit S{L, g}; pg8::EpiSsm1 E{E2}; pg8::gemm_phase<512, 256, 256>(lds, g1, S, E, tid); }
                    asm volatile("s_waitcnt vmcnt(0)" ::: "memory");
                    { PH_LOCALS
                    if (wave < 2) { const int d = wave, p = lane;
                        unsigned* base = (unsigned*)(A2 + ((size_t)(g * A2R + bl * 256) * 512 + 256 + d * 128 + p * 2));
                        const unsigned* ebase = (const unsigned*)(E2 + ((size_t)(g * A2R + bl * 256) * 256 + d * 128 + p * 2));
                        const f32x2 l16 = LP[((((size_t)layer * 2 + d) * 32 + g) * 64 + p) * 18 + 16];
                        float sr = 0.f, si = 0.f;
#pragma unroll 1
                        for (int i0 = 0; i0 < NCH; i0 += 48) {
                            unsigned e[48];
#pragma unroll
                            for (int j = 0; j < 48; ++j) { const int i = i0 + j; const int c = d == 0 ? i : (i < 16 ? 15 - i : 159 - i); e[j] = ebase[(size_t)c * 128]; }
#pragma unroll
                            for (int j = 0; j < 48; ++j) { const int i = i0 + j; const int c = d == 0 ? i : (i < 16 ? 15 - i : 159 - i);
                                base[(size_t)c * 256] = cvt_pk_bf16(sr, si);
                                const float er = bflo(e[j]), ei = bfhi(e[j]); const float nr = l16.x * sr - l16.y * si + er, ni = l16.x * si + l16.y * sr + ei; sr = nr; si = ni; }
                        }
                    }
                    }
                    asm volatile("s_waitcnt vmcnt(0)" ::: "memory"); __syncthreads();
                    asm volatile("s_waitcnt vmcnt(0)" ::: "memory");
                    { PH_LOCALS pg8::Gemm g2{A2, TRl}; pg8::OneUnit S{L, g}; pg8::EpiSsm2 E{Yb}; pg8::gemm_phase<512, 512, 512>(lds, g2, S, E, tid); }
                }
                { PH_LOCALS
                const long ncv = (long)(last ? ML : MH) * 64; const float* cw = INP(7) + layer * 3 * 512;
                for (long it0 = gt; it0 < ncv; it0 += 3 * NGT) {
                    u32x4 rc[3][3], ra[3][3], rb[3]; bool ok[3], hasm[3], hasp[3]; size_t offs[3]; int cc[3];
#pragma unroll
                    for (int j = 0; j < 3; ++j) { const long it = it0 + j * NGT; ok[j] = it < ncv; const long itc = ok[j] ? it : it0;
                        const int m = (int)(itc >> 6), c0 = (int)(itc & 63) * 8; int t, tl; if (m < ML) { t = m & 2047; tl = 2047; } else { t = (m - ML) & 255; tl = 255; }
                        hasm[j] = t > 0; hasp[j] = t < tl; const size_t off = (size_t)m * 512 + c0; offs[j] = off; cc[j] = c0;
                        const size_t om = hasm[j] ? off - 512 : off, op = hasp[j] ? off + 512 : off;
                        rc[j][0] = *(const u32x4*)(CGb + om); ra[j][0] = *(const u32x4*)(AX + om); rc[j][1] = *(const u32x4*)(CGb + off); ra[j][1] = *(const u32x4*)(AX + off);
                        rc[j][2] = *(const u32x4*)(CGb + op); ra[j][2] = *(const u32x4*)(AX + op); rb[j] = *(const u32x4*)(BGb + off); }
#pragma unroll
                    for (int j = 0; j < 3; ++j) { float t1[8], t2[8], bg[8], o[8]; const int c0 = cc[j]; const float fm = hasm[j] ? 1.f : 0.f, fp = hasp[j] ? 1.f : 0.f;
#pragma unroll
                        for (int q = 0; q < 8; ++q) o[q] = 0.f;
#pragma unroll
                        for (int k = 0; k < 3; ++k) { unpack8(rc[j][k], t1); unpack8(ra[j][k], t2); const float f = k == 0 ? fm : (k == 2 ? fp : 1.f);
#pragma unroll
                            for (int q = 0; q < 8; ++q) o[q] += cw[k * 512 + c0 + q] * (t1[q] * t2[q] * f); }
                        unpack8(rb[j], bg);
#pragma unroll
                        for (int q = 0; q < 8; ++q) o[q] *= bg[q];
                        if (ok[j]) *(u32x4*)(CV + offs[j]) = pack8(o); }
                } }
            }
            RUNP(5) {
                { PH_LOCALS
                const int v = (G % 8 == 0) ? (bx % 8) * (G / 8) + bx / 8 : bx;
                const int nun = 512 + (last ? 0 : 64);
                for (int un = v; un < nun; un += G) {
                    if (un < 512) { const int pr = un >> 5, w = un & 31, bl = pr >> 1, kvh = pr & 1, h = kvh * 4 + (w >> 3), qb = w & 7;
                        bf16_t* Qb = QO + (size_t)(bl * 2048 + qb * 256) * 1024 + h * 128;
                        att::attn_dense_body(Qb, KB + (size_t)bl * SEQA * 256 + kvh * 128, VB + (size_t)bl * SEQA * 256 + kvh * 128, O2 + (Qb - QO), SEQA, (char*)lds_raw, tid, wave);
                    } else { const int w = un - 512, bl = w >> 3, h = w & 7, kvh = h >> 2;
                        bf16_t* Qb = QO + (size_t)(ML + bl * 256) * 1024 + h * 128;
                        att::attn_dense_body(Qb, KB + (size_t)bl * SEQA * 256 + kvh * 128, VB + (size_t)bl * SEQA * 256 + kvh * 128, O2 + (Qb - QO), CTX, (char*)lds_raw, tid, wave);
                    }
                } }
            }
            SEAM();
            RUNP(7) {
                const int nMm = (last ? ML : MH) / 256;
                { PH_LOCALS pg8::Gemm g{CV, (bf16_t*)(WSP(WS_WB + WO_CO * 2))}; pg8::Order S; S.init(nMm, 4, G, bx); pg8::EpiMerge<0> E{ws}; pg8::gemm_phase<512, 512, 512>(lds, g, S, E, tid); }
                asm volatile("s_waitcnt vmcnt(0)" ::: "memory"); asm volatile("s_waitcnt vmcnt(0)" ::: "memory"); __syncthreads();
                { PH_LOCALS pg8::Gemm g{Yb, (bf16_t*)(WSP(WS_WB + WO_GLU * 2))}; pg8::Order S; S.init(nMm, 4, G, bx); S.sub = 2; pg8::EpiMerge<1> E{ws}; pg8::gemm_phase<512, 512, 512>(lds, g, S, E, tid); }
                asm volatile("s_waitcnt vmcnt(0)" ::: "memory"); asm volatile("s_waitcnt vmcnt(0)" ::: "memory"); __syncthreads();
                { PH_LOCALS pg8::Gemm g{O2, (bf16_t*)(WSP(WS_WB + WO_AO * 2))}; pg8::Order S; S.init(nMm, 4, G, bx); pg8::EpiMerge<2> E{ws}; pg8::gemm_phase<D, D, D>(lds, g, S, E, tid); }
            }
            SEAM();
            if (hf == 1) {
            RUNP(8) { g_phase<layer, 1>(a, lds, G0, bx0, wave0); }
            SEAM();
            }
}

template <int layer>
__device__ __forceinline__ void ffn_full(const Args& a, LAS unsigned char* lds, unsigned char* lds_raw, int& ph, const XcdBarrier& xbar, const int G0, const int bx0, const int wave0) {
    constexpr bool last = (layer == DEPTH - 1);
            RUNP(9) { PH_LOCALS
                const float* lg = INP(22) + layer * D; const float* lb = INP(23) + layer * D;
                constexpr int NR = last ? FML : FMH;
                for (int mb = gw; mb < NR; mb += 4 * NGW) {
                    f32x4 v[4][4]; int mm[4]; bool ok[4];
#pragma unroll
                    for (int j = 0; j < 4; ++j) { const int m = mb + j * NGW; ok[j] = m < NR; mm[j] = ok[j] ? m : mb;
                        ld_row(v[j], mm[j] < FML ? a.out + (size_t)mm[j] * D : CTXRES + (size_t)(mm[j] - FML) * D, lane); }
#pragma unroll
                    for (int j = 0; j < 4; ++j) { const bool lat = mm[j] < FML; float* rx = lat ? a.out + (size_t)mm[j] * D : CTXRES + (size_t)(mm[j] - FML) * D;
                        const float* mv = modL + (size_t)(lat ? (mm[j] >> 11) : 16) * 6144;
                        post_norm_regs(v[j], rx, lg, lb, true, mv + 3072, mv + 4096, HbF + (size_t)mm[j] * D, lane, ok[j], false, STATS + 2 * (size_t)mm[j]); }
                }
            }
            SEAM();
            RUNP(10) { PH_LOCALS pg8::Gemm g{HbF, (bf16_t*)(WSP(WS_WB + WO_UP * 2))}; pg8::Order S; S.init((last ? FML : FMH) / 256, 2 * DFF / 256, G, bx);
                pg8::EpiUp E{ACTF, SBF, INP(25) + (size_t)layer * 3 * DFF, INP(26) + (size_t)layer * DFF, (LAS float*)(lds + 131072 + 1024)}; pg8::gemm_phase<D, D, D>(lds, g, S, E, tid); }
            SEAM();
            RUNP(12) {
                { PH_LOCALS
                pg8::Order S; S.init((last ? FML : FMH) / 256, 4, G, bx); pg8::Unit u;
                const float* fw = INP(25) + (size_t)layer * 3 * DFF; const float* fb = INP(26) + (size_t)layer * DFF;
                for (int i = 0; S.next(i, u); ++i) {
                    const int pm = u.pm; const bool lat = pm < FML / 256; const bool seq_first = lat ? (pm & 7) == 0 : true, seq_last = lat ? (pm & 7) == 7 : true;
                    const float* sb = SBF + (size_t)pm * 6 * DFF;
#pragma unroll
                    for (int it_ = 0; it_ < (2 * DFF) / 512; ++it_) { const int idx = tid + it_ * 512; const int which = idx >= DFF ? 1 : 0, c = idx - which * DFF;
                        float pv, uc, nx, vv;
                        if (which == 0) { pv = seq_first ? 0.f : sb[-3 * DFF + c]; uc = sb[c]; nx = sb[DFF + c]; vv = sb[4 * DFF + c]; }
                        else { pv = sb[2 * DFF + c]; uc = sb[3 * DFF + c]; nx = seq_last ? 0.f : sb[6 * DFF + c]; vv = sb[5 * DFF + c]; }
                        const float o = gelu_t(fw[c] * pv + fw[DFF + c] * uc + fw[2 * DFF + c] * nx + fb[c]) * vv;
                        ACTF[(size_t)(pm * 256 + (which ? 255 : 0)) * DFF + c] = (bf16_t)(cvt_pk_bf16(o, 0.f) & 0xffffu); }
                }
                asm volatile("s_waitcnt vmcnt(0)" ::: "memory"); __syncthreads(); }
                { PH_LOCALS
                pg8::Gemm g{ACTF, (bf16_t*)(WSP(WS_WB + WO_DN * 2))}; pg8::Order S; S.init((last ? FML : FMH) / 256, 4, G, bx);
                pg8::EpiRes<true> E{a.out, CTXRES, a.out, CTXRES, modL + 5120, 0, FML, STATS, INP(22) + layer * D, INP(23) + layer * D, 0, FML}; pg8::gemm_phase<DFF, DFF, DFF>(lds, g, S, E, tid); }
            }
            SEAM();
            RUNP(13) {
                if (!last) convert_weights<layer + 1>(a, lds, G0, bx0, wave0);
                { PH_LOCALS
                const float* lg = INP(28) + layer * D; const float* lb = INP(29) + layer * D;
                const float* modN = MODV + (size_t)(last ? layer : layer + 1) * 17 * 6144;
                constexpr int NR = last ? FML : FMH;
                for (int mb = gw; mb < NR; mb += 4 * NGW) {
                    f32x4 v[4][4]; int mm[4]; bool ok[4];
#pragma unroll
                    for (int j = 0; j < 4; ++j) { const int m = mb + j * NGW; ok[j] = m < NR; mm[j] = ok[j] ? m : mb;
                        ld_row(v[j], mm[j] < FML ? a.out + (size_t)mm[j] * D : CTXRES + (size_t)(mm[j] - FML) * D, lane); }
#pragma unroll
                    for (int j = 0; j < 4; ++j) { const bool lat = mm[j] < FML; float* rx = lat ? a.out + (size_t)mm[j] * D : CTXRES + (size_t)(mm[j] - FML) * D;
                        const float* mv = modN + (size_t)(lat ? (mm[j] >> 11) : 16) * 6144;
                        post_norm_regs(v[j], rx, lg, lb, !last, mv, mv + 1024, HbF + (size_t)hrow_of(mm[j]) * D, lane, ok[j], last, STATS + 2 * (size_t)mm[j]); }
                } }
            }
            SEAM();
}

__global__ void __launch_bounds__(512) mega_fwd(Args a) {
    extern __shared__ __attribute__((aligned(16))) unsigned char lds_raw[];
    LAS unsigned char* lds = (LAS unsigned char*)lds_raw;
    cg::grid_group grid = cg::this_grid();
    const int G0 = gridDim.x, bx0 = blockIdx.x, wave0 = __builtin_amdgcn_readfirstlane(threadIdx.x >> 6);
    int ph = 0;
    if (blockIdx.x == 0) for (int i = threadIdx.x; i < XCD_BAR_WORDS; i += 512) __hip_atomic_store((unsigned*)a.ws + i, 0u, __ATOMIC_RELAXED, __HIP_MEMORY_SCOPE_AGENT);
    if (threadIdx.x < 64) ((volatile LAS unsigned*)(lds + 131072))[threadIdx.x] = 0u;
    __syncthreads();

    RUNP(0) {
        { PH_LOCALS
        LAS float* sl = (LAS float*)lds;
        LAS float* red = (LAS float*)(lds + 17 * 1024 * 4);
        if (bx < 2 * 96) {
            for (int i = tid; i < 17 * 1024; i += 512) { const int j = i >> 10, k = i & 1023; const float v = j < 16 ? c_in[j * 1024 + k] : cctx_in[k]; sl[i] = v * sigm(v); }
            __syncthreads();
            for (int it = bx; it < 2 * 96; it += G) {
                const int layer = it / 96, n = (it % 96) * 64 + lane;
                const float* W = INP(4) + (size_t)layer * D * 6144;
                float acc[17];
#pragma unroll
                for (int j = 0; j < 17; ++j) acc[j] = 0.f;
                for (int k = wave * 128; k < wave * 128 + 128; ++k) { const float w = W[(size_t)k * 6144 + n];
#pragma unroll
                    for (int j = 0; j < 17; ++j) acc[j] += sl[j * 1024 + k] * w; }
#pragma unroll
                for (int j = 0; j < 17; ++j) red[(wave * 17 + j) * 64 + lane] = acc[j];
                __syncthreads();
                for (int i = tid; i < 17 * 64; i += 512) { const int j = i >> 6, l = i & 63; float s = 0.f;
                    for (int w = 0; w < 8; ++w) s += red[(w * 17 + j) * 64 + l];
                    const int nn = (it % 96) * 64 + l; MODV[((size_t)layer * 17 + j) * 6144 + nn] = s + INP(5)[layer * 6144 + nn]; }
                __syncthreads();
            }
        }
        }
        { PH_LOCALS
        for (long i = gt; i < 2048 * 64; i += NGT) { const int t = (int)(i >> 6), pi = (int)(i & 63);
            const int j = pi & 31; const float inv = 1.0f / powf(10000.0f, (float)(2 * j) / 64.0f);
            const float pos = pi < 32 ? (float)(t >> 6) : (float)(t & 63); const float ang = pos * inv;
            ROPEC[i] = cosf(ang); ROPES[i] = sinf(ang); }
        }
        { PH_LOCALS
        for (long i = gt; i < 2 * 2 * 32 * 64; i += NGT) {
            const int p = (int)(i & 63), g = (int)((i >> 6) & 31), ld = (int)(i >> 11);
            const float lre = INP(9)[i], lim = INP(10)[i]; const float dt = expf(INP(11)[ld * 32 + g]);
            f32x2* o = LP + i * 18;
            for (int k = 0; k <= 16; ++k) { const float m = expf(lre * dt * (float)k), an = lim * dt * (float)k; o[k] = (f32x2){m * cosf(an), m * sinf(an)}; }
            const float m1 = expf(lre * dt), a1 = lim * dt; const float nr = m1 * cosf(a1) - 1.0f, ni = m1 * sinf(a1); const float den = lre * lre + lim * lim;
            o[17] = (f32x2){(nr * lre + ni * lim) / den, (ni * lre - nr * lim) / den};
            (void)p;
        }
        }
    }
    ++ph; if (ph > a.ph_lo && ph < a.ph_hi) grid.sync();
    XcdBarrier xbar; xbar.bar = (unsigned*)a.ws; xbar.x = 0; xbar.st = (volatile LAS unsigned*)(lds + 131072);
    if (a.ph_hi - a.ph_lo > 1) xbar = xcd_barrier_post((unsigned*)a.ws, (volatile LAS unsigned*)(lds + 131072));
    RUNP(1) {
        { PH_LOCALS
        for (long i = gt; i < 2 * 2 * 32 * 4096; i += NGT) {
            const int hp = (int)(i & 15), h = (int)((i >> 4) & 15), k = (int)((i >> 8) & 15); const int ldg = (int)(i >> 12);
            const float* cre = INP(14) + (size_t)ldg * 1024 + h * 64; const float* cim = INP(15) + (size_t)ldg * 1024 + h * 64;
            const float* bre = INP(12) + (size_t)ldg * 1024 + hp; const float* bim = INP(13) + (size_t)ldg * 1024 + hp;
            const f32x2* lp = LP + (size_t)ldg * 64 * 18; float s = 0.f;
            for (int p = 0; p < 64; ++p) { const f32x2 L = lp[p * 18 + k], bb = lp[p * 18 + 17];
                const float br = bre[p * 16], bi = bim[p * 16]; const float xr = bb.x * br - bb.y * bi, xi = bb.x * bi + bb.y * br;
                const float yr = L.x * xr - L.y * xi, yi = L.x * xi + L.y * xr;
                s += cre[p] * yr - cim[p] * yi; }
            KT[i] = s;
        }
        }
        { PH_LOCALS
        for (long i = gt; i < 2L * 32 * 256 * 32; i += NGT) {
            const int k8 = (int)(i & 31), n = (int)((i >> 5) & 255), g = (int)((i >> 13) & 31), l = (int)(i >> 18);
            const int d = n >> 7, p = (n >> 1) & 63, cpt = n & 1, tau = k8 >> 1, h0 = (k8 & 1) * 8;
            const size_t ldg = ((size_t)l * 2 + d) * 32 + g; const f32x2* lp = LP + (ldg * 64 + p) * 18;
            const f32x2 L = lp[d == 0 ? 15 - tau : tau], bb = lp[17]; const float zr = L.x * bb.x - L.y * bb.y, zi = L.x * bb.y + L.y * bb.x;
            const float* bre = INP(12) + ldg * 1024 + p * 16 + h0; const float* bim = INP(13) + ldg * 1024 + p * 16 + h0; float o[8];
#pragma unroll
            for (int j = 0; j < 8; ++j) o[j] = cpt == 0 ? zr * bre[j] - zi * bim[j] : zr * bim[j] + zi * bre[j];
            *(u32x4*)(EBm + (((size_t)l * 32 + g) * 256 + n) * 256 + k8 * 8) = pack8(o);
        }
        }
        { PH_LOCALS
        for (long i = gt; i < 2L * 32 * 256 * 32; i += NGT) {
            const int k8 = (int)(i & 31), n = (int)((i >> 5) & 255), g = (int)((i >> 13) & 31), l = (int)(i >> 18);
            const int d = k8 >> 4, p0 = (k8 & 15) * 4, tau = n >> 4, h = n & 15;
            const size_t ldg = ((size_t)l * 2 + d) * 32 + g; float o[8];
#pragma unroll
            for (int q = 0; q < 4; ++q) { const int p = p0 + q; const f32x2 L = LP[(ldg * 64 + p) * 18 + (d == 0 ? tau + 1 : 16 - tau)];
                const float cr = INP(14)[ldg * 1024 + h * 64 + p], ci = INP(15)[ldg * 1024 + h * 64 + p];
                o[2 * q] = cr * L.x - ci * L.y; o[2 * q + 1] = -(cr * L.y + ci * L.x); }
            *(u32x4*)(TRm + (((size_t)l * 32 + g) * 256 + n) * 512 + 256 + k8 * 8) = pack8(o);
        }
        }
    }
    SEAM();

    if (RUN()) {
        convert_weights<0>(a, lds, G0, bx0, wave0);
        { PH_LOCALS
        const float* mod0 = MODV;
        for (int mb = gw; mb < FMH; mb += 4 * NGW) {
            f32x4 v[4][4]; int mm[4]; bool ok[4];
#pragma unroll
            for (int j = 0; j < 4; ++j) { const int m = mb + j * NGW; ok[j] = m < FMH; mm[j] = ok[j] ? m : mb;
                ld_row(v[j], mm[j] < FML ? x_in + (size_t)mm[j] * D : ctx_in + (size_t)(mm[j] - FML) * D, lane); }
#pragma unroll
            for (int j = 0; j < 4; ++j) { const float* mv = mod0 + (size_t)(mm[j] < FML ? (mm[j] >> 11) : 16) * 6144;
                ln_mod_regs(v[j], mv, mv + 1024, HbF + (size_t)hrow_of(mm[j]) * D, lane, ok[j]); }
        } }
    }
    SEAM();
    layer_half<0, 0>(a, lds, lds_raw, ph, xbar, G0, bx0, wave0);
    layer_half<0, 1>(a, lds, lds_raw, ph, xbar, G0, bx0, wave0);
    ffn_full<0>(a, lds, lds_raw, ph, xbar, G0, bx0, wave0);
    layer_half<1, 0>(a, lds, lds_raw, ph, xbar, G0, bx0, wave0);
    layer_half<1, 1>(a, lds, lds_raw, ph, xbar, G0, bx0, wave0);
    ffn_full<1>(a, lds, lds_raw, ph, xbar, G0, bx0, wave0);
}
constexpr int N_PHASES = 3 + DEPTH * (3 + 4 + 4);

extern "C" void kernel_launch(void* const* d_in, const int* in_sizes, int n_in, void* d_out, int out_size, void* d_ws, size_t ws_size, hipStream_t stream) {
    static int grid = 0;
    if (grid == 0) {
        if (n_in != 30 || out_size != NBATCH * SEQ * D || ws_size < WS_FEND || ws_size < WS_O2 + 36 * MiB) { fprintf(stderr, "kernel_launch: unexpected shapes (n_in %d out %d ws %zu)\n", n_in, out_size, ws_size); grid = -1; return; }
        int dev = 0, cus = 0, per_cu = 0;
        hipGetDevice(&dev); hipDeviceGetAttribute(&cus, hipDeviceAttributeMultiprocessorCount, dev);
        if (hipFuncSetAttribute((const void*)mega_fwd, hipFuncAttributeMaxDynamicSharedMemorySize, LDS_BYTES) != hipSuccess) { fprintf(stderr, "kernel_launch: hipFuncSetAttribute failed\n"); grid = -1; return; }
        if (hipOccupancyMaxActiveBlocksPerMultiprocessor(&per_cu, (const void*)mega_fwd, 512, LDS_BYTES) != hipSuccess || per_cu < 1) { fprintf(stderr, "kernel_launch: occupancy query gave %d\n", per_cu); per_cu = 1; (void)hipGetLastError(); }
        grid = cus * per_cu;
    }
    if (grid < 0) return;
    Args a{};
    for (int i = 0; i < 30; ++i) a.in[i] = (const float*)d_in[i];
    a.out = (float*)d_out; a.ws = (unsigned char*)d_ws;
#if MK_MULTI
    for (int p = 0; p < N_PHASES; ++p) { a.ph_lo = p; a.ph_hi = p + 1; hipLaunchKernelGGL(mega_fwd, dim3(grid), dim3(512), LDS_BYTES, stream, a); }
#else
    a.ph_lo = 0; a.ph_hi = N_PHASES;
    void* args[] = {&a};
    hipError_t e = hipLaunchCooperativeKernel((void*)mega_fwd, dim3(grid), dim3(512), args, LDS_BYTES, stream);
    if (e != hipSuccess) fprintf(stderr, "kernel_launch: cooperative launch failed: %s (grid %d)\n", hipGetErrorString(e), grid);
#endif
}
```
